# Optimizing an MI355X kernel written in HIP

```python
import jax, jax.numpy as jnp
from jax import lax
import numpy as np

D_MODEL = 2048
BATCH = 4
SEQ = 2048
DEPTH = 4

CHUNK = 64
MEM_LEN = 256
HEAD_DIM = 128
QBLOCK = 128
ROPE_THETA = 10000.0
LN_EPS = 1e-5
NEG_INF = -1e30

N_HEADS_A = D_MODEL // (2 * HEAD_DIM)
N_HEADS_B = D_MODEL // (2 * HEAD_DIM)
IDX_HEADS = 16
IDX_DIM = 64
TOPK_MAX = 256
LEFT_CHUNKS = 8
BAND = (LEFT_CHUNKS + 1) * CHUNK
REL_CLIP = 128
REL_SIZE = CHUNK + REL_CLIP
N_HEADS_C = D_MODEL // HEAD_DIM
N_HEADS_X = 4
FFN_DIM = ((8 * D_MODEL // 3 + 255) // 256) * 256
ALPHA = (2.0 * DEPTH) ** 0.25
BETA = (8.0 * DEPTH) ** -0.25
N_EVEN = (DEPTH + 1) // 2
N_ODD = DEPTH // 2
EVEN_SIZES = (N_HEADS_A * HEAD_DIM, HEAD_DIM, HEAD_DIM, IDX_HEADS * IDX_DIM, IDX_DIM, IDX_HEADS,
              N_HEADS_B * HEAD_DIM, N_HEADS_B * HEAD_DIM, N_HEADS_B * HEAD_DIM)
EVEN_COLS = sum(EVEN_SIZES)
ODD_COLS = 3 * N_HEADS_C * HEAD_DIM

kernel_name = 'hybrid_streaming_encoder'


def layer_norm(x, g, b):
    xf = x.astype(jnp.float32)
    mu = jnp.mean(xf, axis=-1, keepdims=True)
    var = jnp.mean(jnp.square(xf - mu), axis=-1, keepdims=True)
    return ((xf - mu) * lax.rsqrt(var + LN_EPS) * g + b).astype(x.dtype)


def rope(x, pos):
    half = x.shape[-1] // 2
    inv_freq = ROPE_THETA ** (-jnp.arange(half, dtype=jnp.float32) / half)
    ang = pos.astype(jnp.float32)[:, None] * inv_freq[None, :]
    cos = jnp.cos(ang)[:, None, :]
    sin = jnp.sin(ang)[:, None, :]
    xf = x.astype(jnp.float32)
    x1, x2 = xf[..., :half], xf[..., half:]
    return jnp.concatenate([x1 * cos - x2 * sin, x2 * cos + x1 * sin], axis=-1).astype(x.dtype)


def split_cols(h, sizes):
    out, o = [], 0
    for n in sizes:
        out.append(h[..., o:o + n])
        o += n
    return out


def swiglu(x, w_in, w_out):
    h = x @ w_in
    a, g = h[..., :FFN_DIM], h[..., FFN_DIM:]
    return (jax.nn.silu(a) * g) @ w_out


def dsa_sparse_attention(q, k, v, qi, ki, wi):
    B, S, H, dh = q.shape
    topk = min(TOPK_MAX, S // 4)
    nb = S // QBLOCK
    key_chunk = jnp.arange(S) // CHUNK
    ki32 = ki.astype(jnp.float32)
    scale = dh ** -0.5

    def block(args):
        qb, qib, wib, bi = args
        q_chunk = (bi * QBLOCK + jnp.arange(QBLOCK)) // CHUNK
        allowed = key_chunk[None, :] <= q_chunk[:, None]
        rel = jax.nn.relu(jnp.einsum('bthd,bsd->bths', qib.astype(jnp.float32), ki32))
        score = jnp.einsum('bths,bth->bts', rel, wib.astype(jnp.float32))
        score = jnp.where(allowed[None], score, NEG_INF)
        _, idx = lax.top_k(score, topk)
        valid = jnp.take(key_chunk, idx) <= q_chunk[None, :, None]
        kg = jax.vmap(lambda kk, ii: kk[ii])(k, idx)
        vg = jax.vmap(lambda vv, ii: vv[ii])(v, idx)
        logits = jnp.einsum('bthd,btkd->bhtk', qb, kg, preferred_element_type=jnp.float32) * scale
        logits = jnp.where(valid[:, None], logits, NEG_INF)
        p = jax.nn.softmax(logits, axis=-1)
        return jnp.einsum('bhtk,btkd->bthd', p.astype(vg.dtype), vg)

    qs = q.reshape(B, nb, QBLOCK, H, dh).transpose(1, 0, 2, 3, 4)
    qis = qi.reshape(B, nb, QBLOCK, IDX_HEADS, IDX_DIM).transpose(1, 0, 2, 3, 4)
    wis = wi.reshape(B, nb, QBLOCK, IDX_HEADS).transpose(1, 0, 2, 3)
    o = lax.map(block, (qs, qis, wis, jnp.arange(nb)))
    return o.transpose(1, 0, 2, 3, 4).reshape(B, S, H, dh)


def chunk_band_attention(q, k, v, rel_bias):
    B, S, H, dh = q.shape
    nc = S // CHUNK
    pad = LEFT_CHUNKS * CHUNK
    kp = jnp.pad(k, ((0, 0), (pad, 0), (0, 0), (0, 0)))
    vp = jnp.pad(v, ((0, 0), (pad, 0), (0, 0), (0, 0)))
    dist = jnp.arange(CHUNK)[:, None] - jnp.arange(BAND)[None, :] + pad
    bias = rel_bias[:, jnp.clip(dist, -(CHUNK - 1), REL_CLIP) + (CHUNK - 1)].astype(jnp.float32)
    scale = dh ** -0.5

    def block(args):
        qb, c = args
        kb = lax.dynamic_slice_in_dim(kp, c * CHUNK, BAND, axis=1)
        vb = lax.dynamic_slice_in_dim(vp, c * CHUNK, BAND, axis=1)
        valid = (c * CHUNK - pad + jnp.arange(BAND)) >= 0
        logits = jnp.einsum('bihd,bjhd->bhij', qb, kb, preferred_element_type=jnp.float32) * scale + bias
        logits = jnp.where(valid, logits, NEG_INF)
        p = jax.nn.softmax(logits, axis=-1)
        return jnp.einsum('bhij,bjhd->bihd', p.astype(vb.dtype), vb)

    qc = q.reshape(B, nc, CHUNK, H, dh).transpose(1, 0, 2, 3, 4)
    o = lax.map(block, (qc, jnp.arange(nc)))
    return o.transpose(1, 0, 2, 3, 4).reshape(B, S, H, dh)


def stick_breaking_attention(q, k, v):
    B, S, H, dh = q.shape
    nb = S // QBLOCK
    kpos = jnp.arange(S)
    scale = dh ** -0.5

    def block(args):
        qb, bi = args
        t = bi * QBLOCK + jnp.arange(QBLOCK)
        z = jnp.einsum('bthd,bshd->bhts', qb, k, preferred_element_type=jnp.float32) * scale
        past = kpos[None, :] < t[:, None]
        log_beta = jax.nn.log_sigmoid(z)
        log_keep = jnp.where(past, jax.nn.log_sigmoid(-z), 0.0)
        after = lax.cumsum(log_keep, axis=3, reverse=True) - log_keep
        a = jnp.where(past, jnp.exp(log_beta + after), 0.0)
        return jnp.einsum('bhts,bshd->bthd', a.astype(v.dtype), v)

    qs = q.reshape(B, nb, QBLOCK, H, dh).transpose(1, 0, 2, 3, 4)
    o = lax.map(block, (qs, jnp.arange(nb)))
    return o.transpose(1, 0, 2, 3, 4).reshape(B, S, H, dh)


def even_mixer(x, w_in, w_out, rel_bias, pos):
    B, S, _ = x.shape
    q_a, k_a, v_a, q_i, k_i, w_i, q_b, k_b, v_b = split_cols(x @ w_in, EVEN_SIZES)
    q_a = rope(q_a.reshape(B, S, N_HEADS_A, HEAD_DIM), pos)
    k_a = rope(k_a.reshape(B, S, 1, HEAD_DIM), pos)[:, :, 0]
    q_i = rope(q_i.reshape(B, S, IDX_HEADS, IDX_DIM), pos)
    k_i = rope(k_i.reshape(B, S, 1, IDX_DIM), pos)[:, :, 0]
    o_a = dsa_sparse_attention(q_a, k_a, v_a, q_i, k_i, w_i)
    o_b = chunk_band_attention(q_b.reshape(B, S, N_HEADS_B, HEAD_DIM),
                               k_b.reshape(B, S, N_HEADS_B, HEAD_DIM),
                               v_b.reshape(B, S, N_HEADS_B, HEAD_DIM), rel_bias)
    o = jnp.concatenate([o_a.reshape(B, S, -1), o_b.reshape(B, S, -1)], axis=-1)
    return o @ w_out


def odd_mixer(x, w_in, w_out):
    B, S, _ = x.shape
    qkv = (x @ w_in).reshape(B, S, 3, N_HEADS_C, HEAD_DIM)
    o = stick_breaking_attention(qkv[:, :, 0], qkv[:, :, 1], qkv[:, :, 2])
    return o.reshape(B, S, -1) @ w_out


def memory_cross_attention(x, mem, w_q, w_kv, w_o):
    B, S, _ = x.shape
    M = mem.shape[1]
    q = (x @ w_q).reshape(B, S, N_HEADS_X, HEAD_DIM)
    kv = (mem @ w_kv).reshape(B, M, 2, N_HEADS_X, HEAD_DIM)
    logits = jnp.einsum('bthd,bmhd->bhtm', q, kv[:, :, 0], preferred_element_type=jnp.float32) * HEAD_DIM ** -0.5
    p = jax.nn.softmax(logits, axis=-1)
    o = jnp.einsum('bhtm,bmhd->bthd', p.astype(kv.dtype), kv[:, :, 1])
    return o.reshape(B, S, -1) @ w_o


def setup_inputs(seed: int = 0) -> dict:
    key = jax.random.key(seed)
    ks = jax.random.split(key, 14)
    f32 = jnp.float32
    D = D_MODEL

    def w(k, shape, fan_in, scale=1.0):
        return jax.random.normal(k, shape, f32) * (scale * fan_in ** -0.5)

    return {
        'x': jax.random.normal(ks[0], (BATCH, SEQ, D), f32),
        'mem': jax.random.normal(ks[1], (BATCH, MEM_LEN, D), f32),
        'ln_g': 1.0 + 0.05 * jax.random.normal(ks[2], (DEPTH, 4, D), f32),
        'ln_b': 0.02 * jax.random.normal(ks[3], (DEPTH, 4, D), f32),
        'ffn_in': w(ks[4], (DEPTH, 2, D, 2 * FFN_DIM), D),
        'ffn_out': w(ks[5], (DEPTH, 2, FFN_DIM, D), FFN_DIM, BETA),
        'xattn_q': w(ks[6], (DEPTH, D, N_HEADS_X * HEAD_DIM), D),
        'xattn_kv': w(ks[7], (DEPTH, D, 2 * N_HEADS_X * HEAD_DIM), D),
        'xattn_o': w(ks[8], (DEPTH, N_HEADS_X * HEAD_DIM, D), N_HEADS_X * HEAD_DIM, BETA),
        'even_in': w(ks[9], (N_EVEN, D, EVEN_COLS), D),
        'even_out': w(ks[10], (N_EVEN, (N_HEADS_A + N_HEADS_B) * HEAD_DIM, D), (N_HEADS_A + N_HEADS_B) * HEAD_DIM, BETA),
        'even_rel_bias': 0.2 * jax.random.normal(ks[11], (N_EVEN, N_HEADS_B, REL_SIZE), f32),
        'odd_in': w(ks[12], (N_ODD, D, ODD_COLS), D),
        'odd_out': w(ks[13], (N_ODD, N_HEADS_C * HEAD_DIM, D), N_HEADS_C * HEAD_DIM, BETA),
    }


def reference(x, mem, ln_g, ln_b, ffn_in, ffn_out, xattn_q, xattn_kv, xattn_o,
              even_in, even_out, even_rel_bias, odd_in, odd_out):
    pos = jnp.arange(x.shape[1])
    for layer in range(DEPTH):
        g, b = ln_g[layer], ln_b[layer]
        x = layer_norm(ALPHA * x + 0.5 * swiglu(x, ffn_in[layer, 0], ffn_out[layer, 0]), g[0], b[0])
        if layer % 2 == 0:
            i = layer // 2
            mix = even_mixer(x, even_in[i], even_out[i], even_rel_bias[i], pos)
        else:
            i = layer // 2
            mix = odd_mixer(x, odd_in[i], odd_out[i])
        x = layer_norm(ALPHA * x + mix, g[1], b[1])
        x = layer_norm(ALPHA * x + memory_cross_attention(x, mem, xattn_q[layer], xattn_kv[layer], xattn_o[layer]), g[2], b[2])
        x = layer_norm(ALPHA * x + 0.5 * swiglu(x, ffn_in[layer, 1], ffn_out[layer, 1]), g[3], b[3])
    return x
```

```cpp
#include <hip/hip_runtime.h>
#include <cstdio>
#include <cstdint>

#define DEVI __device__ __forceinline__
#define LAS __attribute__((address_space(3)))
typedef unsigned short bf16_t;
typedef short bf16x8 __attribute__((ext_vector_type(8)));
typedef float f32x4 __attribute__((ext_vector_type(4)));
typedef float f32x2 __attribute__((ext_vector_type(2)));
typedef unsigned u32x4 __attribute__((ext_vector_type(4)));
typedef unsigned u32x2 __attribute__((ext_vector_type(2)));
typedef unsigned long long u64;

constexpr int DM = 2048, NB = 4, SEQ = 2048, MT = NB * SEQ, DEPTH = 4, FFN = 5632, HD = 128, MEML = 256;
constexpr int EVEN_COLS = 5456, EVP = 5632, ODD_COLS = 6144, RELSZ = 192;
constexpr float ALPHA = 1.681792830507429f;
constexpr float SCALE = 0.08838834764831845f;
constexpr float LN_EPS = 1e-5f;
constexpr int EV_QA = 0, EV_KA = 1024, EV_VA = 1152, EV_QI = 1280, EV_KI = 2304, EV_WI = 2368, EV_QB = 2560, EV_KB = 3584, EV_VB = 4608;

constexpr size_t MiB = 1ull << 20;
constexpr size_t WS_CTL = 0;
constexpr size_t WS_ROPE128 = 1 * MiB;
constexpr size_t WS_ROPE64 = 2 * MiB;
constexpr size_t WS_WF_FFN_IN = 3 * MiB;
constexpr size_t SZ_FFN_IN = (size_t)2 * FFN * DM * 2;
constexpr size_t WS_W_FFN_OUT = WS_WF_FFN_IN + 8 * SZ_FFN_IN;
constexpr size_t SZ_FFN_OUT = (size_t)DM * FFN * 2;
constexpr size_t WS_WF_EVEN_IN = WS_W_FFN_OUT + 8 * SZ_FFN_OUT;
constexpr size_t SZ_EVEN_IN = (size_t)EVP * DM * 2;
constexpr size_t WS_W_ODD_IN = WS_WF_EVEN_IN + 2 * SZ_EVEN_IN;
constexpr size_t SZ_ODD_IN = (size_t)ODD_COLS * DM * 2;
constexpr size_t WS_W_MIX_OUT = WS_W_ODD_IN + 2 * SZ_ODD_IN;
constexpr size_t SZ_MIX_OUT = (size_t)DM * DM * 2;
constexpr size_t WS_W_XQ = WS_W_MIX_OUT + 4 * SZ_MIX_OUT;
constexpr size_t SZ_XQ = (size_t)512 * DM * 2;
constexpr size_t WS_W_XKV = WS_W_XQ + 4 * SZ_XQ;
constexpr size_t SZ_XKV = (size_t)1024 * DM * 2;
constexpr size_t WS_W_XO = WS_W_XKV + 4 * SZ_XKV;
constexpr size_t SZ_XO = (size_t)DM * 512 * 2;
constexpr size_t WS_WN_FFN_IN = WS_W_XO + 4 * SZ_XO;
constexpr size_t WS_WN_EVEN_IN = WS_WN_FFN_IN + 8 * SZ_FFN_IN;
constexpr size_t SZ_WN_EVEN_IN = (size_t)5472 * DM * 2;
constexpr size_t WS_X = ((WS_WN_EVEN_IN + 2 * SZ_WN_EVEN_IN + MiB - 1) / MiB) * MiB;
constexpr size_t WS_XB = WS_X + 64 * MiB;
constexpr size_t WS_Y = WS_XB + 32 * MiB;
constexpr size_t WS_H = WS_Y + 64 * MiB;
constexpr size_t WS_QKV = WS_H + 88 * MiB;
constexpr size_t WS_O = WS_QKV + 96 * MiB;
constexpr size_t WS_XQ = WS_O + 32 * MiB;
constexpr size_t WS_XO = WS_XQ + 8 * MiB;
constexpr size_t WS_KVX = WS_XO + 8 * MiB;
constexpr size_t WS_MEMB = WS_KVX + 8 * MiB;
constexpr size_t WS_SCORES = WS_MEMB + 4 * MiB;
constexpr size_t WS_MASK = WS_SCORES + 64 * MiB;
constexpr size_t WS_C = WS_MASK + 2 * MiB;
constexpr size_t WS_END = WS_C + 352 * MiB;

DEVI float bf2f(bf16_t v) { return __uint_as_float(((unsigned)v) << 16); }
DEVI unsigned f2bf(float f) { unsigned u = __float_as_uint(f); return (u + 0x7fffu + ((u >> 16) & 1u)) >> 16; }
DEVI unsigned pk2(float lo, float hi) { return f2bf(lo) | (f2bf(hi) << 16); }
DEVI float wave_sum(float v) {
#pragma unroll
    for (int o = 32; o >= 1; o >>= 1) v += __shfl_xor(v, o);
    return v;
}
DEVI float wave_max(float v) {
#pragma unroll
    for (int o = 32; o >= 1; o >>= 1) v = fmaxf(v, __shfl_xor(v, o));
    return v;
}

DEVI void map_group(int mode, int dg, int nsrc, int& s0, int& nv) {
    nv = 32;
    if (mode == 0) { s0 = 32 * dg; int rem = nsrc - s0; nv = rem < 0 ? 0 : (rem > 32 ? 32 : rem); }
    else if (mode == 1) { const int pn = dg >> 3, r = (dg & 7) * 32; s0 = (r < 128) ? pn * 128 + r : FFN + pn * 128 + (r - 128); }
    else {
        const int pn = dg >> 3, q = dg & 7, bj = q >> 2, j = (q & 3) * 32;
        if (pn < 4) { const int g = j >> 6; s0 = pn * 256 + g * 128 + bj * 64 + (j & 63); }
        else if (pn == 4) { const int g = j >> 6; s0 = 1024 + g * 128 + bj * 64 + (j & 63); }
        else if (pn < 9) { const int g = j >> 5; s0 = 1280 + (pn - 5) * 256 + g * 64 + bj * 32; }
        else if (pn == 9) { const int g = j >> 5; if (g == 0) s0 = 2304 + bj * 32; else if (g == 1 && bj == 0) { s0 = 2368; nv = 16; } else { s0 = 0; nv = 0; } }
        else { s0 = 2384 + (pn - 10) * 256 + q * 32; }
    }
}
DEVI void transpose_item(const float* W, int ldw, int s0, int nv, bf16_t* WT, int K, int drow0, int k0, LAS float* scr, int lane) {
#pragma unroll 8
    for (int i = 0; i < 32; ++i) { const int kk = 2 * i + (lane >> 5); const int c = lane & 31;
        scr[kk * 33 + c] = (c < nv) ? W[(size_t)(k0 + kk) * ldw + s0 + c] : 0.f; }
    asm volatile("s_waitcnt lgkmcnt(0)" ::: "memory");
    const int c = lane & 7;
#pragma unroll
    for (int j = 0; j < 4; ++j) { const int n = (lane >> 3) + 8 * j; const LAS float* s = scr + (8 * c) * 33 + n;
        u32x4 o; o.x = pk2(s[0 * 33], s[1 * 33]); o.y = pk2(s[2 * 33], s[3 * 33]); o.z = pk2(s[4 * 33], s[5 * 33]); o.w = pk2(s[6 * 33], s[7 * 33]);
        *(u32x4*)(WT + (size_t)(drow0 + n) * K + k0 + 8 * c) = o; }
    asm volatile("s_waitcnt lgkmcnt(0)" ::: "memory");
}
DEVI void convert_matrix(const float* W, int ldw, int nsrc, int K, bf16_t* WT, int ngroups, int mode, int gw, int ngw, LAS float* scr, int lane) {
    const int nkb = K / 64, nitems = ngroups * nkb;
    for (int it = gw; it < nitems; it += ngw) {
        const int dg = it / nkb, kb = it % nkb; int s0, nv; map_group(mode, dg, nsrc, s0, nv);
        transpose_item(W, ldw, s0, nv, WT, K, dg * 32, kb * 64, scr, lane);
    }
}
__global__ __launch_bounds__(512) void k_convert(const float* W, int ldw, int nsrc, int K, bf16_t* WT, int ngroups, int mode) {
    extern __shared__ __attribute__((aligned(16))) unsigned char dyn_lds[];
    const int wave = threadIdx.x >> 6, lane = threadIdx.x & 63;
    LAS float* scr = (LAS float*)((LAS unsigned char*)dyn_lds + wave * 8448);
    convert_matrix(W, ldw, nsrc, K, WT, ngroups, mode, blockIdx.x * 8 + wave, gridDim.x * 8, scr, lane);
}

__global__ __launch_bounds__(256) void k_rope_tables(f32x2* t128, f32x2* t64) {
    const int i = blockIdx.x * 256 + threadIdx.x;
    if (i < SEQ * 96) {
        const int pos = i / 96, f = i % 96; const bool big = f < 64; const int ff = big ? f : f - 64; const double half = big ? 64.0 : 32.0;
        const double inv = exp2(-(double)ff / half * 13.287712379549449);
        const double rev = (double)pos * inv * 0.15915494309189535; const double fr = rev - rint(rev);
        const float c = __builtin_amdgcn_cosf((float)fr), s = __builtin_amdgcn_sinf((float)fr);
        if (big) t128[pos * 64 + ff] = (f32x2){c, s}; else t64[pos * 32 + ff] = (f32x2){c, s};
    }
}
__global__ __launch_bounds__(256) void k_cvt_x(const float* x, float* X, bf16_t* XB, size_t n4) {
    for (size_t i = blockIdx.x * 256ull + threadIdx.x; i < n4; i += gridDim.x * 256ull) {
        const f32x4 v = ((const f32x4*)x)[i]; if (X) ((f32x4*)X)[i] = v;
        u32x2 o; o.x = pk2(v.x, v.y); o.y = pk2(v.z, v.w); ((u32x2*)XB)[i] = o; }
}

__global__ __launch_bounds__(512) void k_gemm_naive(const bf16_t* A, int lda, const bf16_t* Bt, int ldb, float* C, int ldc, int M, int N, int K) {
    const int gw = blockIdx.x * 8 + (threadIdx.x >> 6), ngw = gridDim.x * 8, lane = threadIdx.x & 63;
    const int ntn = N / 16, ntm = M / 32;
    for (int t = gw; t < ntm * ntn; t += ngw) {
        const int tm = t / ntn, tn = t % ntn;
        const bf16_t* a0 = A + (size_t)(tm * 32 + (lane & 15)) * lda + 8 * (lane >> 4);
        const bf16_t* a1 = a0 + (size_t)16 * lda;
        const bf16_t* b = Bt + (size_t)(tn * 16 + (lane & 15)) * ldb + 8 * (lane >> 4);
        f32x4 c0 = {0.f, 0.f, 0.f, 0.f}, c1 = {0.f, 0.f, 0.f, 0.f};
#pragma unroll 4
        for (int k = 0; k < K; k += 32) {
            const bf16x8 fa0 = *(const bf16x8*)(a0 + k), fa1 = *(const bf16x8*)(a1 + k), fb = *(const bf16x8*)(b + k);
            c0 = __builtin_amdgcn_mfma_f32_16x16x32_bf16(fa0, fb, c0, 0, 0, 0);
            c1 = __builtin_amdgcn_mfma_f32_16x16x32_bf16(fa1, fb, c1, 0, 0, 0);
        }
#pragma unroll
        for (int r = 0; r < 4; ++r) {
            C[(size_t)(tm * 32 + (lane >> 4) * 4 + r) * ldc + tn * 16 + (lane & 15)] = c0[r];
            C[(size_t)(tm * 32 + 16 + (lane >> 4) * 4 + r) * ldc + tn * 16 + (lane & 15)] = c1[r];
        }
    }
}

__global__ __launch_bounds__(256) void k_swiglu(const float* C, bf16_t* H) {
    for (size_t i = blockIdx.x * 256ull + threadIdx.x; i < (size_t)MT * FFN; i += gridDim.x * 256ull) {
        const size_t m = i / FFN, j = i % FFN; const float a = C[m * 2 * FFN + j], g = C[m * 2 * FFN + FFN + j];
        H[i] = (bf16_t)f2bf(a / (1.f + expf(-a)) * g); }
}
__global__ __launch_bounds__(256) void k_resid(const float* C, const float* X, float* Y, float cscale) {
    for (size_t i = blockIdx.x * 256ull + threadIdx.x; i < (size_t)MT * DM; i += gridDim.x * 256ull) Y[i] = ALPHA * X[i] + cscale * C[i];
}
__global__ __launch_bounds__(256) void k_tobf(const float* C, bf16_t* O, size_t n) {
    for (size_t i = blockIdx.x * 256ull + threadIdx.x; i < n; i += gridDim.x * 256ull) O[i] = (bf16_t)f2bf(C[i]);
}
DEVI void ln_row(const float* y, const float* g, const float* b, float* x, bf16_t* xb, float* out, int lane) {
    f32x4 v[8]; float s = 0.f;
#pragma unroll
    for (int j = 0; j < 8; ++j) { v[j] = ((const f32x4*)y)[lane + 64 * j]; s += (v[j].x + v[j].y) + (v[j].z + v[j].w); }
    const float mean = wave_sum(s) * (1.f / DM); float s2 = 0.f;
#pragma unroll
    for (int j = 0; j < 8; ++j) { v[j] = v[j] - mean; s2 += (v[j].x * v[j].x + v[j].y * v[j].y) + (v[j].z * v[j].z + v[j].w * v[j].w); }
    const float rstd = 1.f / sqrtf(wave_sum(s2) * (1.f / DM) + LN_EPS);
#pragma unroll
    for (int j = 0; j < 8; ++j) { const f32x4 gg = ((const f32x4*)g)[lane + 64 * j], bb = ((const f32x4*)b)[lane + 64 * j];
        const f32x4 o = v[j] * rstd * gg + bb; ((f32x4*)x)[lane + 64 * j] = o; if (out) ((f32x4*)out)[lane + 64 * j] = o;
        u32x2 w; w.x = pk2(o.x, o.y); w.y = pk2(o.z, o.w); ((u32x2*)xb)[lane + 64 * j] = w; }
}
__global__ __launch_bounds__(512) void k_ln(const float* Y, const float* g, const float* b, float* X, bf16_t* XB, float* OUT) {
    const int gw = blockIdx.x * 8 + (threadIdx.x >> 6), ngw = gridDim.x * 8, lane = threadIdx.x & 63;
    for (int m = gw; m < MT; m += ngw) ln_row(Y + (size_t)m * DM, g, b, X + (size_t)m * DM, XB + (size_t)m * DM, OUT ? OUT + (size_t)m * DM : nullptr, lane);
}
__global__ __launch_bounds__(256) void k_even_split(const float* C, bf16_t* EV, const f32x2* t128, const f32x2* t64) {
    for (size_t i = blockIdx.x * 256ull + threadIdx.x; i < (size_t)MT * EVP; i += gridDim.x * 256ull) {
        const int m = (int)(i / EVP), dcol = (int)(i % EVP), pos = m % SEQ; const float* c = C + (size_t)m * EVEN_COLS;
        float v = 0.f;
        if (dcol < 2384) {
            const int s = dcol;
            if (s < 1152) {
                const int d = s & 127;
                if (d < 64) { const f32x2 cs = t128[pos * 64 + d]; v = c[s] * cs.x - c[s + 64] * cs.y; }
                else { const f32x2 cs = t128[pos * 64 + d - 64]; v = c[s] * cs.x + c[s - 64] * cs.y; }
            } else if (s < 1280) v = c[s];
            else if (s < 2368) {
                const int d = (s - 1280) & 63;
                if (d < 32) { const f32x2 cs = t64[pos * 32 + d]; v = c[s] * cs.x - c[s + 32] * cs.y; }
                else { const f32x2 cs = t64[pos * 32 + d - 32]; v = c[s] * cs.x + c[s - 32] * cs.y; }
            } else v = c[s];
        } else if (dcol >= 2560) v = c[dcol - 176];
        EV[i] = (bf16_t)f2bf(v);
    }
}

DEVI void indexer_naive_phase(const bf16_t* EV, float* SC, LAS unsigned char* lds, int wave, int lane, int gw, int ngw) {
    LAS float* qf = (LAS float*)(lds + wave * 8192);
    for (int m = gw; m < MT; m += ngw) {
        const int b = m / SEQ, t = m % SEQ, nk = (t / 64 + 1) * 64;
        const bf16_t* qrow = EV + (size_t)m * EVP + EV_QI;
        for (int i = lane; i < 1024; i += 64) qf[i] = bf2f(qrow[i]);
        if (lane < 16) qf[1024 + lane] = bf2f(EV[(size_t)m * EVP + EV_WI + lane]);
        asm volatile("s_waitcnt lgkmcnt(0)" ::: "memory");
        for (int s0 = 0; s0 < nk; s0 += 64) {
            const int s = s0 + lane; const bf16_t* krow = EV + (size_t)(b * SEQ + s) * EVP + EV_KI;
            float kf[64];
#pragma unroll
            for (int i = 0; i < 8; ++i) { const bf16x8 kv = *(const bf16x8*)(krow + 8 * i);
#pragma unroll
                for (int e = 0; e < 8; ++e) kf[8 * i + e] = bf2f((bf16_t)kv[e]); }
            float sc = 0.f;
#pragma unroll 1
            for (int h = 0; h < 16; ++h) { float d = 0.f;
#pragma unroll
                for (int e = 0; e < 64; ++e) d += qf[h * 64 + e] * kf[e];
                sc += qf[1024 + h] * fmaxf(d, 0.f); }
            SC[(size_t)m * SEQ + s] = sc;
        }
        asm volatile("s_waitcnt lgkmcnt(0)" ::: "memory");
    }
}
__global__ __launch_bounds__(512) void k_indexer_naive(const bf16_t* EV, float* SC) {
    extern __shared__ __attribute__((aligned(16))) unsigned char dyn_lds[];
    const int wave = threadIdx.x >> 6, lane = threadIdx.x & 63;
    indexer_naive_phase(EV, SC, (LAS unsigned char*)dyn_lds, wave, lane, blockIdx.x * 8 + wave, gridDim.x * 8);
}

DEVI unsigned ordkey(float f) { const unsigned u = __float_as_uint(f); return (u & 0x80000000u) ? ~u : (u | 0x80000000u); }
DEVI void select_row(const float* sc, int c  , u64* mrow, int lane) {
    if (c < 4) { if (lane <= c) mrow[lane] = ~0ull; return; }
    unsigned u[32];
#pragma unroll
    for (int j = 0; j < 32; ++j) u[j] = (j <= c) ? ordkey(sc[64 * j + lane]) : 0u;
    unsigned T = 0u;
#pragma unroll 1
    for (int bit = 31; bit >= 0; --bit) {
        const unsigned cand = T | (1u << bit); int cnt = 0;
#pragma unroll
        for (int j = 0; j < 32; ++j) if (j <= c) cnt += __popcll(__ballot(u[j] >= cand));
        if (cnt >= 256) T = cand;
    }
    int ngt = 0;
#pragma unroll
    for (int j = 0; j < 32; ++j) if (j <= c) ngt += __popcll(__ballot(u[j] > T));
    int need = 256 - ngt;
#pragma unroll
    for (int j = 0; j < 32; ++j) if (j <= c) {
        const u64 gt = __ballot(u[j] > T); u64 eq = __ballot(u[j] == T);
        int ne = __popcll(eq); const int take = ne < need ? ne : need;
        while (ne > take) { eq &= ~(1ull << (63 - __clzll(eq))); --ne; }
        need -= take;
        if (lane == 0) mrow[j] = gt | eq;
    }
}
__global__ __launch_bounds__(512) void k_select(const float* SC, u64* MASK) {
    const int gw = blockIdx.x * 8 + (threadIdx.x >> 6), ngw = gridDim.x * 8, lane = threadIdx.x & 63;
    for (int m = gw; m < MT; m += ngw) select_row(SC + (size_t)m * SEQ, (m % SEQ) / 64, MASK + (size_t)m * 32, lane);
}

struct AttnArgs { const bf16_t* Q; const bf16_t* K; const bf16_t* V; bf16_t* O; const float* bias; const u64* mask;
                  int ldq, qoff, ldk, koff, ldv, voff, ldo, ooff, nheads, kvshared; };
DEVI float log_sigmoid(float z) { return fminf(z, 0.f) - log1pf(expf(-fabsf(z))); }
template <int MODE> DEVI void attn_naive_phase(const AttnArgs& a, LAS unsigned char* lds, int wave, int lane, int gw, int ngw) {
    LAS float* sc = (LAS float*)(lds + wave * 8704);
    const int ntask = MT * a.nheads;
    for (int task = gw; task < ntask; task += ngw) {
        const int m = task / a.nheads, h = task % a.nheads, b = m / SEQ, t = m % SEQ, c = t / 64, kh = a.kvshared ? 0 : h;
        int s_lo, s_hi, rowbase;
        if (MODE == 0) { s_lo = 0; s_hi = MEML; rowbase = b * MEML; }
        else if (MODE == 1) { s_lo = (c - 8) * 64; if (s_lo < 0) s_lo = 0; s_hi = (c + 1) * 64; rowbase = b * SEQ; }
        else if (MODE == 2) { s_lo = 0; s_hi = (c + 1) * 64; rowbase = b * SEQ; }
        else { s_lo = 0; s_hi = t; rowbase = b * SEQ; }
        const unsigned qq = *(const unsigned*)(a.Q + (size_t)m * a.ldq + a.qoff + h * HD + 2 * lane);
        const float q0 = bf2f((bf16_t)(qq & 0xffffu)), q1 = bf2f((bf16_t)(qq >> 16));
        const bf16_t* Kb = a.K + (size_t)rowbase * a.ldk + a.koff + kh * HD + 2 * lane;
        const bf16_t* Vb = a.V + (size_t)rowbase * a.ldv + a.voff + kh * HD + 2 * lane;
        for (int s = s_lo; s < s_hi; ++s) {
            bool sel = true;
            if (MODE == 2) sel = (a.mask[(size_t)m * 32 + (s >> 6)] >> (s & 63)) & 1ull;
            float z = -INFINITY;
            if (sel) { const unsigned kk = *(const unsigned*)(Kb + (size_t)s * a.ldk);
                z = wave_sum(q0 * bf2f((bf16_t)(kk & 0xffffu)) + q1 * bf2f((bf16_t)(kk >> 16))) * SCALE;
                if (MODE == 1) { int dist = t - s; dist = dist < -63 ? -63 : (dist > 128 ? 128 : dist); z += a.bias[h * RELSZ + dist + 63]; } }
            if (lane == 0) sc[s - s_lo] = z;
        }
        asm volatile("s_waitcnt lgkmcnt(0)" ::: "memory");
        const int n = s_hi - s_lo;
        if (MODE != 3) {
            float mx = -INFINITY; for (int i = lane; i < n; i += 64) mx = fmaxf(mx, sc[i]);
            mx = wave_max(mx);
            float sum = 0.f; for (int i = lane; i < n; i += 64) { const float p = expf(sc[i] - mx); sc[i] = p; sum += p; }
            sum = wave_sum(sum); const float inv = 1.f / sum;
            for (int i = lane; i < n; i += 64) sc[i] *= inv;
        } else {
            const int lo = 32 * lane, hi = (lo + 32 < n) ? lo + 32 : n;
            float cs = 0.f; for (int i = lo; i < hi; ++i) cs += log_sigmoid(-sc[i]);
            sc[2048 + lane] = cs;
            asm volatile("s_waitcnt lgkmcnt(0)" ::: "memory");
            float run = 0.f; for (int l2 = 63; l2 > lane; --l2) run += sc[2048 + l2];
            for (int i = hi - 1; i >= lo; --i) { const float z = sc[i]; sc[i] = expf(log_sigmoid(z) + run); run += log_sigmoid(-z); }
        }
        asm volatile("s_waitcnt lgkmcnt(0)" ::: "memory");
        float o0 = 0.f, o1 = 0.f;
        for (int s = s_lo; s < s_hi; ++s) { const float w = sc[s - s_lo];
            if (w != 0.f) { const unsigned vv = *(const unsigned*)(Vb + (size_t)s * a.ldv); o0 += w * bf2f((bf16_t)(vv & 0xffffu)); o1 += w * bf2f((bf16_t)(vv >> 16)); } }
        *(unsigned*)(a.O + (size_t)m * a.ldo + a.ooff + h * HD + 2 * lane) = pk2(o0, o1);
        asm volatile("s_waitcnt lgkmcnt(0)" ::: "memory");
    }
}
template <int MODE> __global__ __launch_bounds__(512) void k_attn_naive(AttnArgs a) {
    extern __shared__ __attribute__((aligned(16))) unsigned char dyn_lds[];
    const int wave = threadIdx.x >> 6, lane = threadIdx.x & 63;
    attn_naive_phase<MODE>(a, (LAS unsigned char*)dyn_lds, wave, lane, blockIdx.x * 8 + wave, gridDim.x * 8);
}


namespace pg8 {
#define PG8_LAS __attribute__((address_space(3)))
typedef unsigned short bf16_t;
typedef short bf16x8 __attribute__((ext_vector_type(8)));
typedef float f32x4 __attribute__((ext_vector_type(4)));
typedef unsigned u32x4 __attribute__((ext_vector_type(4)));
constexpr int BM = 256, BK = 64, HALF = 128, HTB = HALF * BK * 2  , STAGE_BYTES = 8 * HTB, NXCD = 8, WGM = 8;

__host__ __device__ __forceinline__ int lds_byte(int r, int c) { const int st = (r >> 4) * 2 + (c >> 5), rr = r & 15, cc = c & 31, ob = rr * 64 + cc * 2; return st * 1024 + (ob ^ (((ob >> 9) & 1) << 5)); }
__host__ __device__ __forceinline__ void stage_rc(int b, int& R, int& C) { const int st = b / 1024, sb = b % 1024, swz = sb ^ (((sb >> 9) & 1) << 5); R = (st >> 1) * 16 + swz / 64; C = (st & 1) * 32 + (swz % 64) / 2; }
__host__ __device__ __forceinline__ int perm32(int rho) { const int n = rho >> 4, i = rho & 15; return 8 * (i >> 2) + 4 * n + (i & 3); }

struct Unit { int pm, pn; };
struct Gemm { const bf16_t* A; const bf16_t* Bt; int M, N, K; };

struct StaticOrder {
    int nM, nN, nwg, G, c;
    __host__ __device__ void init(int M, int N, int G_, int c_) { nM = M / BM; nN = N / BM; nwg = nM * nN; G = G_; c = c_; }
    __host__ __device__ bool next(int i, Unit& u) const {
        const long L = (long)i * G + c; if (L >= nwg) return false;
        int wgid = (int)L; { const int q = nwg / NXCD, r = nwg % NXCD, xcd = wgid % NXCD, off = wgid / NXCD; wgid = (xcd < r ? xcd * (q + 1) : r * (q + 1) + (xcd - r) * q) + off; }
        const int nig = WGM * nN, gid = wgid / nig, fm = gid * WGM, gsz = (nM - fm) < WGM ? (nM - fm) : WGM;
        u.pm = fm + ((wgid % nig) % gsz); u.pn = (wgid % nig) / gsz; return true;
    }
    __device__ __forceinline__ void a_ready(const Unit&) const {}
    __device__ __forceinline__ void done(const Unit&) const {}
};

__device__ __forceinline__ unsigned cvt_pk_bf16(float lo, float hi) { unsigned r; asm volatile("v_cvt_pk_bf16_f32 %0, %1, %2" : "=v"(r) : "v"(lo), "v"(hi)); return r; }
struct EpiBf16 {
    static constexpr bool PERM = true, AFTER_DRAIN = false;
    bf16_t* O; int ldc;
    __device__ __forceinline__ void operator()(const f32x4 (&acc)[2][2][4][2], const Unit& u, int wr, int wc, int fr, int fq) const {
        const int row0 = u.pm * BM + wr * 64 + fr, col0 = u.pn * BM + wc * 32 + 8 * fq;
#pragma unroll
        for (int ai = 0; ai < 2; ++ai)
#pragma unroll
            for (int m = 0; m < 4; ++m) { bf16_t* rowp = O + (size_t)(row0 + ai * HALF + m * 16) * ldc + col0;
#pragma unroll
                for (int bj = 0; bj < 2; ++bj) { const f32x4 v0 = acc[ai][bj][m][0], v1 = acc[ai][bj][m][1];
                    u32x4 w; w.x = cvt_pk_bf16(v0[0], v0[1]); w.y = cvt_pk_bf16(v0[2], v0[3]); w.z = cvt_pk_bf16(v1[0], v1[1]); w.w = cvt_pk_bf16(v1[2], v1[3]);
                    *(u32x4*)(rowp + bj * HALF) = w; } }
    }
};
struct EpiSwiglu {
    static constexpr bool PERM = true, AFTER_DRAIN = false;
    bf16_t* H; int ldc;
    static __device__ __forceinline__ float sg(float a, float g) { return a * __builtin_amdgcn_rcpf(1.f + __builtin_amdgcn_exp2f(-1.4426950408889634f * a)) * g; }
    __device__ __forceinline__ void operator()(const f32x4 (&acc)[2][2][4][2], const Unit& u, int wr, int wc, int fr, int fq) const {
        const int row0 = u.pm * BM + wr * 64 + fr, col0 = u.pn * HALF + wc * 32 + 8 * fq;
#pragma unroll
        for (int ai = 0; ai < 2; ++ai)
#pragma unroll
            for (int m = 0; m < 4; ++m) { bf16_t* rowp = H + (size_t)(row0 + ai * HALF + m * 16) * ldc + col0;
                const f32x4 a0 = acc[ai][0][m][0], a1 = acc[ai][0][m][1], g0 = acc[ai][1][m][0], g1 = acc[ai][1][m][1];
                u32x4 w; w.x = cvt_pk_bf16(sg(a0[0], g0[0]), sg(a0[1], g0[1])); w.y = cvt_pk_bf16(sg(a0[2], g0[2]), sg(a0[3], g0[3]));
                w.z = cvt_pk_bf16(sg(a1[0], g1[0]), sg(a1[1], g1[1])); w.w = cvt_pk_bf16(sg(a1[2], g1[2]), sg(a1[3], g1[3]));
                *(u32x4*)rowp = w; }
    }
};
struct EpiRope {
    static constexpr bool PERM = true, AFTER_DRAIN = false;
    bf16_t* EV; int ldc; const f32x2* t128; const f32x2* t64; int seq;
    __device__ __forceinline__ void operator()(const f32x4 (&acc)[2][2][4][2], const Unit& u, int wr, int wc, int fr, int fq) const {
        const int row0 = u.pm * BM + wr * 64 + fr, jj = wc * 32 + 8 * fq, pn = u.pn;
        if (pn >= 10) {
#pragma unroll
            for (int ai = 0; ai < 2; ++ai)
#pragma unroll
                for (int m = 0; m < 4; ++m) { bf16_t* rowp = EV + (size_t)(row0 + ai * HALF + m * 16) * ldc + pn * BM + jj;
#pragma unroll
                    for (int bj = 0; bj < 2; ++bj) { const f32x4 v0 = acc[ai][bj][m][0], v1 = acc[ai][bj][m][1];
                        u32x4 w; w.x = cvt_pk_bf16(v0[0], v0[1]); w.y = cvt_pk_bf16(v0[2], v0[3]); w.z = cvt_pk_bf16(v1[0], v1[1]); w.w = cvt_pk_bf16(v1[2], v1[3]);
                        *(u32x4*)(rowp + bj * HALF) = w; } }
        } else {
            const bool big = pn < 5; const int hw = big ? 64 : 32, g = big ? (jj >> 6) : (jj >> 5), dd = jj & (hw - 1);
            const bool dorope = (pn == 4 || pn == 9) ? (g == 0) : true;
            const f32x2* tab = big ? t128 : t64;
#pragma unroll
            for (int ai = 0; ai < 2; ++ai)
#pragma unroll
                for (int m = 0; m < 4; ++m) { const int row = row0 + ai * HALF + m * 16, pos = row % seq;
                    const f32x4* tp = (const f32x4*)(tab + (size_t)pos * hw + dd);
                    f32x4 cs[4];
#pragma unroll
                    for (int e = 0; e < 4; ++e) cs[e] = dorope ? tp[e] : (f32x4){1.f, 0.f, 1.f, 0.f};
                    float o1[8], o2[8];
#pragma unroll
                    for (int e = 0; e < 8; ++e) { const float x1 = acc[ai][0][m][e >> 2][e & 3], x2 = acc[ai][1][m][e >> 2][e & 3];
                        const float c = (e & 1) ? cs[e >> 1][2] : cs[e >> 1][0], s = (e & 1) ? cs[e >> 1][3] : cs[e >> 1][1];
                        o1[e] = x1 * c - x2 * s; o2[e] = x2 * c + x1 * s; }
                    bf16_t* rowp = EV + (size_t)row * ldc + pn * BM + g * 2 * hw + dd;
                    u32x4 w1, w2; w1.x = cvt_pk_bf16(o1[0], o1[1]); w1.y = cvt_pk_bf16(o1[2], o1[3]); w1.z = cvt_pk_bf16(o1[4], o1[5]); w1.w = cvt_pk_bf16(o1[6], o1[7]);
                    w2.x = cvt_pk_bf16(o2[0], o2[1]); w2.y = cvt_pk_bf16(o2[2], o2[3]); w2.z = cvt_pk_bf16(o2[4], o2[5]); w2.w = cvt_pk_bf16(o2[6], o2[7]);
                    *(u32x4*)rowp = w1; *(u32x4*)(rowp + hw) = w2; }
        }
    }
};
struct EpiResid {
    static constexpr bool PERM = false, AFTER_DRAIN = false;
    const float* X; float* Y; int ldc; float alpha, cs;
    __device__ __forceinline__ void operator()(const f32x4 (&acc)[2][2][4][2], const Unit& u, int wr, int wc, int fr, int fq) const {
        const int col0 = u.pn * BM + wc * 32 + 4 * fq;
#pragma unroll
        for (int ai = 0; ai < 2; ++ai)
#pragma unroll
            for (int m = 0; m < 4; ++m) { const size_t off = (size_t)(u.pm * BM + ai * HALF + wr * 64 + m * 16 + fr) * ldc + col0;
#pragma unroll
                for (int bj = 0; bj < 2; ++bj)
#pragma unroll
                    for (int n = 0; n < 2; ++n) { const f32x4 xv = *(const f32x4*)(X + off + bj * HALF + n * 16);
                        *(f32x4*)(Y + off + bj * HALF + n * 16) = xv * alpha + acc[ai][bj][m][n] * cs; } }
    }
};

template <class Epi, class Sched, bool ALIGN_EPI = false, bool SP2 = false>
__device__ __forceinline__ void gemm_phase(PG8_LAS unsigned char* lds, const Gemm g, const Sched& S, const Epi& E) {
    int tid_ = threadIdx.x; asm volatile("" : "+v"(tid_));
    const int tid = tid_, wid = __builtin_amdgcn_readfirstlane(tid >> 6), lane = tid & 63, wr = wid >> 2, wc = wid & 3, fr = lane & 15, fq = lane >> 4;
    const int K = g.K, nt = K / BK;
    unsigned voffA[2], voffB[2];
#pragma unroll
    for (int i = 0; i < 2; ++i) { int R, C; stage_rc(tid * 16 + i * 8192, R, C); const int Rb = Epi::PERM ? ((R & ~31) + perm32(R & 31)) : R;
        voffA[i] = (unsigned)(R * K + C) * 2u; voffB[i] = (unsigned)(Rb * K + C) * 2u; }
    const size_t kstep = (size_t)(BK * 2);
    const size_t hstep = (size_t)HALF * K * 2;
    const size_t tstep = 2 * hstep;
    const unsigned ldsw = (unsigned)wid * 1024u;
    const int aoff = lds_byte(wr * 64 + fr, fq * 8), boff = lds_byte(wc * 32 + fr, fq * 8);
#define PG8_SA(b, h) (((b) * 2 + (h)) * HTB)
#define PG8_SB(b, h) ((4 + (b) * 2 + (h)) * HTB)
#define PG8_STAGE(bufoff, gbase, voff) do { _Pragma("unroll") for (int _i = 0; _i < 2; ++_i) \
        __builtin_amdgcn_global_load_lds((const unsigned*)((const char*)(gbase) + (voff)[_i]), (PG8_LAS unsigned*)(lds + (bufoff) + ldsw + _i * 8192), 16, 0, 0); } while (0)
#define PG8_LDA(dst, b, h) do { _Pragma("unroll") for (int m = 0; m < 4; ++m) _Pragma("unroll") for (int k = 0; k < 2; ++k) dst[m][k] = *(const PG8_LAS bf16x8*)(lds + PG8_SA(b, h) + aoff + m * 2048 + k * 1024); } while (0)
#define PG8_LDB(dst, b, h) do { _Pragma("unroll") for (int n = 0; n < 2; ++n) _Pragma("unroll") for (int k = 0; k < 2; ++k) dst[n][k] = *(const PG8_LAS bf16x8*)(lds + PG8_SB(b, h) + boff + n * 2048 + k * 1024); } while (0)
#define PG8_MMA(ai, bj, At, Bt) do { __builtin_amdgcn_s_setprio(1); _Pragma("unroll") for (int m = 0; m < 4; ++m) _Pragma("unroll") for (int n = 0; n < 2; ++n) _Pragma("unroll") for (int k = 0; k < 2; ++k) \
        acc[ai][bj][m][n] = __builtin_amdgcn_mfma_f32_16x16x32_bf16(Bt[n][k], At[m][k], acc[ai][bj][m][n], 0, 0, 0); __builtin_amdgcn_s_setprio(0); } while (0)
#define PG8_WAIT_V(n) asm volatile("s_waitcnt vmcnt(" #n ")" ::: "memory")
#define PG8_WAIT_L(n) asm volatile("s_waitcnt lgkmcnt(" #n ")" ::: "memory")
#define PG8_BAR __builtin_amdgcn_s_barrier()
#define PG8_SCHED __builtin_amdgcn_sched_barrier(0)
    Unit cur, nxt; int ui = 0;
    if (!S.next(0, cur)) return;
    f32x4 acc[2][2][4][2];
#pragma unroll
    for (int a = 0; a < 2; ++a)
#pragma unroll
        for (int b = 0; b < 2; ++b)
#pragma unroll
            for (int m = 0; m < 4; ++m)
#pragma unroll
                for (int n = 0; n < 2; ++n) acc[a][b][m][n] = (f32x4){0.f, 0.f, 0.f, 0.f};
    bf16x8 At[4][2], B0[2][2], B1[2][2];
    const char* cA = (const char*)g.A + (size_t)cur.pm * tstep; const char* cB = (const char*)g.Bt + (size_t)cur.pn * tstep;
    S.a_ready(cur);
    if constexpr (SP2) {
        PG8_STAGE(PG8_SB(0, 0), cB, voffB); PG8_STAGE(PG8_SB(0, 1), cB + hstep, voffB); PG8_STAGE(PG8_SA(0, 0), cA, voffA); PG8_STAGE(PG8_SA(0, 1), cA + hstep, voffA);
        if (wr == 1) PG8_BAR;
        PG8_WAIT_V(2); PG8_BAR;
        PG8_STAGE(PG8_SB(1, 0), cB + kstep, voffB); PG8_STAGE(PG8_SA(1, 0), cA + kstep, voffA); PG8_STAGE(PG8_SB(1, 1), cB + hstep + kstep, voffB);
        PG8_WAIT_V(6); PG8_BAR;
    } else {
        PG8_STAGE(PG8_SB(0, 0), cB, voffB); PG8_STAGE(PG8_SA(0, 0), cA, voffA); PG8_STAGE(PG8_SB(0, 1), cB + hstep, voffB); PG8_STAGE(PG8_SA(0, 1), cA + hstep, voffA);
        if (wr == 1) PG8_BAR;
        PG8_WAIT_V(4); PG8_BAR;
        PG8_STAGE(PG8_SB(1, 0), cB + kstep, voffB); PG8_STAGE(PG8_SA(1, 0), cA + kstep, voffA); PG8_STAGE(PG8_SB(1, 1), cB + hstep + kstep, voffB);
        PG8_WAIT_V(6); PG8_BAR;
    }
    for (;;) {
        const bool has_next = S.next(ui + 1, nxt);
        const char* nA = has_next ? (const char*)g.A + (size_t)nxt.pm * tstep : cA; const char* nB = has_next ? (const char*)g.Bt + (size_t)nxt.pn * tstep : cB;
        for (int t = 0; t < nt; t += 2) {
            const bool last = (t == nt - 2);
            const char* a1 = cA + (size_t)(t + 1) * kstep;
            const char* a2 = last ? nA : cA + (size_t)(t + 2) * kstep; const char* b2 = last ? nB : cB + (size_t)(t + 2) * kstep;
            const char* a3 = a2 + kstep; const char* b3 = b2 + kstep;
            if (last && has_next) S.a_ready(nxt);
            if constexpr (SP2) {
            PG8_LDB(B0, 0, 0); PG8_LDB(B1, 0, 1); PG8_SCHED; PG8_LDA(At, 0, 0); PG8_STAGE(PG8_SA(1, 1), a1 + hstep, voffA);
            PG8_WAIT_V(8); PG8_WAIT_L(0); PG8_BAR; PG8_MMA(0, 0, At, B0); PG8_MMA(0, 1, At, B1); PG8_BAR; PG8_SCHED;
            PG8_LDA(At, 0, 1); PG8_STAGE(PG8_SB(0, 0), b2, voffB); PG8_STAGE(PG8_SB(0, 1), b2 + hstep, voffB); PG8_STAGE(PG8_SA(0, 0), a2, voffA);
            PG8_WAIT_V(8); PG8_WAIT_L(0); PG8_BAR; PG8_MMA(1, 0, At, B0); PG8_MMA(1, 1, At, B1); PG8_BAR; PG8_SCHED;
            PG8_LDB(B0, 1, 0); PG8_LDB(B1, 1, 1); PG8_SCHED; PG8_LDA(At, 1, 0); PG8_STAGE(PG8_SA(0, 1), a2 + hstep, voffA);
            PG8_WAIT_V(8); PG8_WAIT_L(0); PG8_BAR; PG8_MMA(0, 0, At, B0); PG8_MMA(0, 1, At, B1); PG8_BAR; PG8_SCHED;
            PG8_LDA(At, 1, 1); PG8_STAGE(PG8_SB(1, 0), b3, voffB); PG8_STAGE(PG8_SB(1, 1), b3 + hstep, voffB); PG8_STAGE(PG8_SA(1, 0), a3, voffA);
            PG8_WAIT_V(8); PG8_WAIT_L(0); PG8_BAR; PG8_MMA(1, 0, At, B0); PG8_MMA(1, 1, At, B1); PG8_BAR; PG8_SCHED;
            } else {
            PG8_LDB(B0, 0, 0); PG8_SCHED; PG8_LDA(At, 0, 0); PG8_STAGE(PG8_SA(1, 1), a1 + hstep, voffA);
            PG8_WAIT_L(8); PG8_BAR; PG8_WAIT_L(0); PG8_MMA(0, 0, At, B0); PG8_BAR; PG8_SCHED;
            PG8_LDB(B1, 0, 1); PG8_STAGE(PG8_SB(0, 0), b2, voffB);
            PG8_BAR; PG8_WAIT_L(0); PG8_MMA(0, 1, At, B1); PG8_BAR;
            PG8_LDA(At, 0, 1); PG8_STAGE(PG8_SA(0, 0), a2, voffA);
            PG8_BAR; PG8_WAIT_L(0); PG8_MMA(1, 0, At, B0); PG8_BAR; PG8_SCHED;
            PG8_STAGE(PG8_SB(0, 1), b2 + hstep, voffB);
            PG8_WAIT_V(6); PG8_BAR; PG8_MMA(1, 1, At, B1); PG8_BAR;
            PG8_LDB(B0, 1, 0); PG8_SCHED; PG8_LDA(At, 1, 0); PG8_STAGE(PG8_SA(0, 1), a2 + hstep, voffA);
            PG8_WAIT_L(8); PG8_BAR; PG8_WAIT_L(0); PG8_MMA(0, 0, At, B0); PG8_BAR; PG8_SCHED;
            PG8_LDB(B1, 1, 1); PG8_STAGE(PG8_SB(1, 0), b3, voffB);
            PG8_BAR; PG8_WAIT_L(0); PG8_MMA(0, 1, At, B1); PG8_BAR;
            PG8_LDA(At, 1, 1); PG8_STAGE(PG8_SA(1, 0), a3, voffA);
            PG8_BAR; PG8_WAIT_L(0); PG8_MMA(1, 0, At, B0); PG8_BAR; PG8_SCHED;
            PG8_STAGE(PG8_SB(1, 1), b3 + hstep, voffB);
            PG8_WAIT_V(6); PG8_BAR; PG8_MMA(1, 1, At, B1); PG8_BAR;
            }
        }
        if constexpr (ALIGN_EPI) { if (wr == 0) PG8_BAR; }
        if constexpr (!Epi::AFTER_DRAIN) { E(acc, cur, wr, wc, fr, fq); S.done(cur); }
        if (!has_next) break;
#pragma unroll
        for (int a = 0; a < 2; ++a)
#pragma unroll
            for (int b = 0; b < 2; ++b)
#pragma unroll
                for (int m = 0; m < 4; ++m)
#pragma unroll
                    for (int n = 0; n < 2; ++n) acc[a][b][m][n] = (f32x4){0.f, 0.f, 0.f, 0.f};
        cur = nxt; cA = nA; cB = nB; ++ui;
        if constexpr (ALIGN_EPI) { if (wr == 1) PG8_BAR; }
    }
    PG8_WAIT_V(0);
    if constexpr (!ALIGN_EPI) { if (wr == 0) PG8_BAR; }
    PG8_BAR;
    if constexpr (Epi::AFTER_DRAIN) { E.fused(acc, cur, wr, wc, fr, fq, lds, wid, lane); S.done(cur); }
#undef PG8_SA
#undef PG8_SB
#undef PG8_STAGE
#undef PG8_LDA
#undef PG8_LDB
#undef PG8_MMA
#undef PG8_WAIT_V
#undef PG8_WAIT_L
#undef PG8_BAR
#undef PG8_SCHED
}
}

#define XB_TMO      128
#define XB_XCNT(j)  (256  + 64 * (j))
#define XB_XSUB(j)  (1280 + 64 * (j))
#define XB_XGEN(j)  (2304 + 64 * (j))
#define XB_TOP      3328
#define XB_TOPGEN   3392
#define XCD_BAR_WORDS 3456
#define XB_SPIN_CAP (1u << 18)

__device__ __forceinline__ unsigned xb_ld(unsigned* p)              { return __hip_atomic_load(p, __ATOMIC_RELAXED, __HIP_MEMORY_SCOPE_AGENT); }
__device__ __forceinline__ unsigned xb_add(unsigned* p, unsigned v) { return __hip_atomic_fetch_add(p, v, __ATOMIC_RELAXED, __HIP_MEMORY_SCOPE_AGENT); }
__device__ __forceinline__ unsigned xb_xcc_id() { return (unsigned)__builtin_amdgcn_s_getreg((3 << 11) | 20) & 0xFu; }
#define XB_SPIN(cond, bar) do { unsigned _sp = 0; while (cond) { __builtin_amdgcn_s_sleep(1); \
    if ((++_sp & 255u) == 0u) { if (xb_ld(&(bar)[XB_TMO])) break; if (_sp > XB_SPIN_CAP) { atomicAdd(&(bar)[XB_TMO], 1u); break; } } } } while (0)

struct XcdBarrier {
    unsigned* bar; unsigned x;
    volatile LAS unsigned* st;
};

__device__ __forceinline__ XcdBarrier xcd_barrier_post(unsigned* bar, volatile LAS unsigned* st) {
    XcdBarrier b; b.bar = bar; b.x = xb_xcc_id(); b.st = st;
    if (threadIdx.x == 0) (void)xb_add(&bar[XB_XCNT(b.x)], 1u);
    return b;
}
__device__ __forceinline__ void xcd_barrier_complete(unsigned* bar, unsigned x, unsigned& nloc, unsigned& nx) {
    const unsigned G = gridDim.x * gridDim.y * gridDim.z;
    unsigned sum, cnt, mine, sp = 0u;
    for (;;) {
        sum = 0u; cnt = 0u; mine = 0u;
#pragma unroll
        for (unsigned j = 0; j < 16; ++j) { const unsigned c = xb_ld(&bar[XB_XCNT(j)]); sum += c; cnt += (c > 0u) ? 1u : 0u; mine = (j == x) ? c : mine; }
        if (sum == G) break;
        __builtin_amdgcn_s_sleep(1);
        if ((++sp & 255u) == 0u) { if (xb_ld(&bar[XB_TMO])) break; if (sp > XB_SPIN_CAP) { atomicAdd(&bar[XB_TMO], 1u); break; } }
    }
    nloc = mine > 0u ? mine : 1u; nx = cnt > 0u ? cnt : 1u;
}

__device__ __forceinline__ void xcd_barrier(const XcdBarrier& b) {
    asm volatile("s_waitcnt vmcnt(0)" ::: "memory");
    __syncthreads();
    if (threadIdx.x == 0) {
        unsigned* bar = b.bar;
        __builtin_amdgcn_s_waitcnt(0);
        unsigned nloc = b.st[0], nx = b.st[1];
        if (nloc == 0u) { xcd_barrier_complete(bar, b.x, nloc, nx); b.st[0] = nloc; b.st[1] = nx; }
        const unsigned old = xb_add(&bar[XB_XSUB(b.x)], 1u);
        const unsigned gen = old / nloc;
        if (old + 1u == (gen + 1u) * nloc) {
            __builtin_amdgcn_fence(__ATOMIC_RELEASE, "agent");
            asm volatile("s_waitcnt vmcnt(0)" ::: "memory");
            const unsigned og = xb_add(&bar[XB_TOP], 1u);
            const unsigned tg = og / nx;
            if (og + 1u == (tg + 1u) * nx) xb_add(&bar[XB_TOPGEN], 1u);
            else XB_SPIN(xb_ld(&bar[XB_TOPGEN]) == tg, bar);
            __builtin_amdgcn_fence(__ATOMIC_ACQUIRE, "agent");
            xb_add(&bar[XB_XGEN(b.x)], 1u);
            asm volatile("s_waitcnt vmcnt(0)" ::: "memory");
        } else {
            XB_SPIN(xb_ld(&bar[XB_XGEN(b.x)]) == gen, bar);
            __builtin_amdgcn_fence(__ATOMIC_ACQUIRE, "agent");
            asm volatile("s_waitcnt vmcnt(0)" ::: "memory");
        }
    }
    __syncthreads();
}

constexpr int RING_BYTES = 131072, LDSCTL_OFF = RING_BYTES, MISC_OFF = LDSCTL_OFF + 320, LDS_BYTES = 147456;
constexpr int CW_BAR = 4096;
constexpr int N_STEPS = 2 + 16 * 8;
struct MegaArgs { const float* in[14]; float* out; unsigned char* ws; int st_lo, st_hi; };

DEVI void prologue_phase(const MegaArgs& a, LAS unsigned char* lds, int wave, int lane, int gw, int ngw) {
    unsigned char* ws = a.ws;
    LAS float* scr = (LAS float*)(lds + wave * 8448);
#pragma unroll 1
    for (int lj = 0; lj < 8; ++lj) {
        convert_matrix(a.in[4] + (size_t)lj * DM * 2 * FFN, 2 * FFN, 2 * FFN, DM, (bf16_t*)(ws + WS_WF_FFN_IN + lj * SZ_FFN_IN), 2 * FFN / 32, 1, gw, ngw, scr, lane);
        convert_matrix(a.in[5] + (size_t)lj * FFN * DM, DM, DM, FFN, (bf16_t*)(ws + WS_W_FFN_OUT + lj * SZ_FFN_OUT), DM / 32, 0, gw, ngw, scr, lane);
    }
#pragma unroll 1
    for (int i = 0; i < 2; ++i) {
        convert_matrix(a.in[9] + (size_t)i * DM * EVEN_COLS, EVEN_COLS, EVEN_COLS, DM, (bf16_t*)(ws + WS_WF_EVEN_IN + i * SZ_EVEN_IN), EVP / 32, 2, gw, ngw, scr, lane);
        convert_matrix(a.in[12] + (size_t)i * DM * ODD_COLS, ODD_COLS, ODD_COLS, DM, (bf16_t*)(ws + WS_W_ODD_IN + i * SZ_ODD_IN), ODD_COLS / 32, 0, gw, ngw, scr, lane);
        convert_matrix(a.in[10] + (size_t)i * DM * DM, DM, DM, DM, (bf16_t*)(ws + WS_W_MIX_OUT + (2 * i) * SZ_MIX_OUT), DM / 32, 0, gw, ngw, scr, lane);
        convert_matrix(a.in[13] + (size_t)i * DM * DM, DM, DM, DM, (bf16_t*)(ws + WS_W_MIX_OUT + (2 * i + 1) * SZ_MIX_OUT), DM / 32, 0, gw, ngw, scr, lane);
    }
#pragma unroll 1
    for (int l = 0; l < DEPTH; ++l) {
        convert_matrix(a.in[6] + (size_t)l * DM * 512, 512, 512, DM, (bf16_t*)(ws + WS_W_XQ + l * SZ_XQ), 512 / 32, 0, gw, ngw, scr, lane);
        convert_matrix(a.in[7] + (size_t)l * DM * 1024, 1024, 1024, DM, (bf16_t*)(ws + WS_W_XKV + l * SZ_XKV), 1024 / 32, 0, gw, ngw, scr, lane);
        convert_matrix(a.in[8] + (size_t)l * 512 * DM, DM, DM, 512, (bf16_t*)(ws + WS_W_XO + l * SZ_XO), DM / 32, 0, gw, ngw, scr, lane);
    }
    const int gt = gw * 64 + lane, ngt = ngw * 64;
    f32x2* t128 = (f32x2*)(ws + WS_ROPE128); f32x2* t64 = (f32x2*)(ws + WS_ROPE64);
    for (int i = gt; i < SEQ * 96; i += ngt) {
        const int pos = i / 96, f = i % 96; const bool big = f < 64; const int ff = big ? f : f - 64; const double half = big ? 64.0 : 32.0;
        const double inv = exp2(-(double)ff / half * 13.287712379549449);
        const double rev = (double)pos * inv * 0.15915494309189535; const double fr = rev - rint(rev);
        const float c = __builtin_amdgcn_cosf((float)fr), s = __builtin_amdgcn_sinf((float)fr);
        if (big) t128[pos * 64 + ff] = (f32x2){c, s}; else t64[pos * 32 + ff] = (f32x2){c, s};
    }
    { const f32x4* x4 = (const f32x4*)a.in[0]; f32x4* X4 = (f32x4*)(ws + WS_X); u32x2* XB2 = (u32x2*)(ws + WS_XB);
      for (int i = gt; i < MT * DM / 4; i += ngt) { const f32x4 v = x4[i]; X4[i] = v; u32x2 o; o.x = pk2(v.x, v.y); o.y = pk2(v.z, v.w); XB2[i] = o; }
      const f32x4* m4 = (const f32x4*)a.in[1]; u32x2* MB2 = (u32x2*)(ws + WS_MEMB);
      for (int i = gt; i < NB * MEML * DM / 4; i += ngt) { const f32x4 v = m4[i]; u32x2 o; o.x = pk2(v.x, v.y); o.y = pk2(v.z, v.w); MB2[i] = o; } }
}

template <class Epi> DEVI void run_gemm(LAS unsigned char* lds, const bf16_t* A, const bf16_t* Bt, int M, int N, int K, const Epi& E) {
    pg8::Gemm g{A, Bt, M, N, K}; pg8::StaticOrder S; S.init(M, N, (int)gridDim.x, (int)blockIdx.x);
    pg8::gemm_phase<Epi, pg8::StaticOrder, true, true>(lds, g, S, E);
}

__global__ void __launch_bounds__(512, 2) k_mega(MegaArgs a) {
    extern __shared__ __attribute__((aligned(16))) unsigned char dyn_lds[];
    LAS unsigned char* lds = (LAS unsigned char*)dyn_lds;
    volatile LAS unsigned* MISC = (volatile LAS unsigned*)(lds + MISC_OFF);
    const int tid = threadIdx.x, lane_k = tid & 63, wave_k = __builtin_amdgcn_readfirstlane(tid >> 6);
    const int ngw = gridDim.x * 8;
    unsigned char* ws = a.ws;
    for (int u = tid; u < (LDS_BYTES - LDSCTL_OFF) / 4; u += 512) ((LAS unsigned*)(lds + LDSCTL_OFF))[u] = 0u;
    __syncthreads();
    XcdBarrier bar = xcd_barrier_post((unsigned*)(ws + WS_CTL) + CW_BAR, MISC + 8);
    const int lo = a.st_lo, hi = a.st_hi; bool prev = false;
#ifndef SITES
#define SITES 0xFFFF
#endif
#define STEP_BEGIN(idx) if (lo <= (idx) && (idx) < hi) { if (prev) xcd_barrier(bar); prev = true; int lane = lane_k, wave = wave_k; asm volatile("" : "+v"(lane), "+s"(wave)); const int gw = blockIdx.x * 8 + wave; (void)gw; (void)lane;
#define STEP_END }
    float* X = (float*)(ws + WS_X); bf16_t* XB = (bf16_t*)(ws + WS_XB); float* Y = (float*)(ws + WS_Y); bf16_t* H = (bf16_t*)(ws + WS_H);
    bf16_t* QKV = (bf16_t*)(ws + WS_QKV); bf16_t* O = (bf16_t*)(ws + WS_O); bf16_t* XQ = (bf16_t*)(ws + WS_XQ); bf16_t* XO = (bf16_t*)(ws + WS_XO);
    bf16_t* KVX = (bf16_t*)(ws + WS_KVX); bf16_t* MEMB = (bf16_t*)(ws + WS_MEMB); float* SC = (float*)(ws + WS_SCORES); u64* MASK = (u64*)(ws + WS_MASK);
    const f32x2* T128 = (const f32x2*)(ws + WS_ROPE128); const f32x2* T64 = (const f32x2*)(ws + WS_ROPE64);

    STEP_BEGIN(0) prologue_phase(a, lds, wave, lane, gw, ngw); STEP_END
    STEP_BEGIN(1) { pg8::EpiBf16 E{KVX, 4096}; run_gemm(lds, MEMB, (const bf16_t*)(ws + WS_W_XKV), NB * MEML, 4096, DM, E); } STEP_END
#pragma unroll 1
    for (int sb = 0; sb < 16; ++sb) {
        const int l = sb >> 2, kind = sb & 3, base = 2 + sb * 8;
        const bf16_t* oA; const bf16_t* oB; int oK; float ocs;
        if (kind == 0 || kind == 3) {
            const int lj = l * 2 + (kind == 3 ? 1 : 0);
            STEP_BEGIN(base + 0) { pg8::EpiSwiglu E{H, FFN}; run_gemm(lds, XB, (const bf16_t*)(ws + WS_WF_FFN_IN + lj * SZ_FFN_IN), MT, 2 * FFN, DM, E); } STEP_END
            oA = H; oB = (const bf16_t*)(ws + WS_W_FFN_OUT + lj * SZ_FFN_OUT); oK = FFN; ocs = 0.5f;
        } else if (kind == 1) {
            const int i = l >> 1;
            if ((l & 1) == 0) {
                STEP_BEGIN(base + 0) { pg8::EpiRope E{QKV, EVP, T128, T64, SEQ}; run_gemm(lds, XB, (const bf16_t*)(ws + WS_WF_EVEN_IN + i * SZ_EVEN_IN), MT, EVP, DM, E); } STEP_END
                STEP_BEGIN(base + 1) {
                    indexer_naive_phase(QKV, SC, lds, wave, lane, gw, ngw);
                    AttnArgs b2{}; b2.Q = QKV; b2.K = QKV; b2.V = QKV; b2.O = O; b2.bias = a.in[11] + (size_t)i * 8 * RELSZ; b2.mask = nullptr;
                    b2.ldq = EVP; b2.qoff = EV_QB; b2.ldk = EVP; b2.koff = EV_KB; b2.ldv = EVP; b2.voff = EV_VB; b2.ldo = DM; b2.ooff = 1024; b2.nheads = 8; b2.kvshared = 0;
                    attn_naive_phase<1>(b2, lds, wave, lane, gw, ngw);
                } STEP_END
                STEP_BEGIN(base + 2) {
                    for (int m = gw; m < MT; m += ngw) select_row(SC + (size_t)m * SEQ, (m % SEQ) / 64, MASK + (size_t)m * 32, lane);
                } STEP_END
                STEP_BEGIN(base + 3) {
                    AttnArgs aa{}; aa.Q = QKV; aa.K = QKV; aa.V = QKV; aa.O = O; aa.bias = nullptr; aa.mask = MASK;
                    aa.ldq = EVP; aa.qoff = EV_QA; aa.ldk = EVP; aa.koff = EV_KA; aa.ldv = EVP; aa.voff = EV_VA; aa.ldo = DM; aa.ooff = 0; aa.nheads = 8; aa.kvshared = 1;
                    attn_naive_phase<2>(aa, lds, wave, lane, gw, ngw);
                } STEP_END
            } else {
                STEP_BEGIN(base + 0) { pg8::EpiBf16 E{QKV, ODD_COLS}; run_gemm(lds, XB, (const bf16_t*)(ws + WS_W_ODD_IN + i * SZ_ODD_IN), MT, ODD_COLS, DM, E); } STEP_END
                STEP_BEGIN(base + 1) {
                    AttnArgs aa{}; aa.Q = QKV; aa.K = QKV; aa.V = QKV; aa.O = O; aa.bias = nullptr; aa.mask = nullptr;
                    aa.ldq = ODD_COLS; aa.qoff = 0; aa.ldk = ODD_COLS; aa.koff = 2048; aa.ldv = ODD_COLS; aa.voff = 4096; aa.ldo = DM; aa.ooff = 0; aa.nheads = 16; aa.kvshared = 0;
                    attn_naive_phase<3>(aa, lds, wave, lane, gw, ngw);
                } STEP_END
            }
            oA = O; oB = (const bf16_t*)(ws + WS_W_MIX_OUT + l * SZ_MIX_OUT); oK = DM; ocs = 1.0f;
        } else {
            STEP_BEGIN(base + 0) { pg8::EpiBf16 E{XQ, 512}; run_gemm(lds, XB, (const bf16_t*)(ws + WS_W_XQ + l * SZ_XQ), MT, 512, DM, E); } STEP_END
            STEP_BEGIN(base + 1) {
                AttnArgs aa{}; aa.Q = XQ; aa.K = KVX; aa.V = KVX; aa.O = XO; aa.bias = nullptr; aa.mask = nullptr;
                aa.ldq = 512; aa.qoff = 0; aa.ldk = 4096; aa.koff = l * 1024; aa.ldv = 4096; aa.voff = l * 1024 + 512; aa.ldo = 512; aa.ooff = 0; aa.nheads = 4; aa.kvshared = 0;
                attn_naive_phase<0>(aa, lds, wave, lane, gw, ngw);
            } STEP_END
            oA = XO; oB = (const bf16_t*)(ws + WS_W_XO + l * SZ_XO); oK = 512; ocs = 1.0f;
        }
        STEP_BEGIN(base + 5) { pg8::EpiResid E{X, Y, DM, ALPHA, ocs}; run_gemm(lds, oA, oB, MT, DM, oK, E); } STEP_END
        STEP_BEGIN(base + 6) {
            const float* g = a.in[2] + (size_t)(l * 4 + kind) * DM; const float* bt = a.in[3] + (size_t)(l * 4 + kind) * DM;
            float* outp = (sb == 15) ? a.out : nullptr;
            for (int m = gw; m < MT; m += ngw) ln_row(Y + (size_t)m * DM, g, bt, X + (size_t)m * DM, XB + (size_t)m * DM, outp ? outp + (size_t)m * DM : nullptr, lane);
        } STEP_END
    }
#undef STEP_BEGIN
#undef STEP_END
}

#ifndef FAST_MASK
#define FAST_MASK 0x1FFF
#endif
enum { F_PROLOGUE = 1, F_KVX = 2, F_FFN_IN = 4, F_EV_IN = 8, F_IDXBAND = 16, F_SELECT = 32, F_DSA = 64, F_OD_IN = 128, F_STICK = 256, F_XQ = 512, F_XATT = 1024, F_OUT = 2048, F_LN = 4096, F_ALL = 0x1FFF };
struct StepInfo { int flag; int sb, l, kind, sub; bool valid; };
static StepInfo step_info(int st) {
    StepInfo s{}; s.valid = true; s.sb = -1;
    if (st == 0) { s.flag = F_PROLOGUE; return s; }
    if (st == 1) { s.flag = F_KVX; return s; }
    const int sb = (st - 2) / 8, sub = (st - 2) % 8, l = sb >> 2, kind = sb & 3; s.sb = sb; s.l = l; s.kind = kind; s.sub = sub;
    if (sub == 5) { s.flag = F_OUT; return s; }
    if (sub == 6) { s.flag = F_LN; return s; }
    if (kind == 0 || kind == 3) { if (sub == 0) s.flag = F_FFN_IN; else s.valid = false; return s; }
    if (kind == 1) {
        if ((l & 1) == 0) { if (sub == 0) s.flag = F_EV_IN; else if (sub == 1) s.flag = F_IDXBAND; else if (sub == 2) s.flag = F_SELECT; else if (sub == 3) s.flag = F_DSA; else s.valid = false; }
        else { if (sub == 0) s.flag = F_OD_IN; else if (sub == 1) s.flag = F_STICK; else s.valid = false; }
        return s; }
    if (sub == 0) s.flag = F_XQ; else if (sub == 1) s.flag = F_XATT; else s.valid = false;
    return s;
}
static void launch_convert(hipStream_t st, const float* W, int ldw, int nsrc, int K, bf16_t* WT, int ngroups, int mode) {
    hipLaunchKernelGGL(k_convert, dim3(1024), dim3(512), 8 * 8448, st, W, ldw, nsrc, K, WT, ngroups, mode);
}
static void launch_gemm(hipStream_t st, const bf16_t* A, int lda, const bf16_t* Bt, int ldb, float* C, int ldc, int M, int N, int K) {
    hipLaunchKernelGGL(k_gemm_naive, dim3(1024), dim3(512), 0, st, A, lda, Bt, ldb, C, ldc, M, N, K);
}
static void launch_mega(hipStream_t stream, const MegaArgs& base, int lo, int hi, int grid, void* d_ws) {
    (void)hipMemsetAsync((char*)d_ws + WS_CTL, 0, 1 * MiB, stream);
    MegaArgs a = base; a.st_lo = lo; a.st_hi = hi;
    hipLaunchKernelGGL(k_mega, dim3(grid), dim3(512), LDS_BYTES, stream, a);
}
extern "C" void kernel_launch(void* const* d_in, const int* in_sizes, int n_in, void* d_out, int out_size, void* d_ws, size_t ws_size, hipStream_t stream) {
    if (n_in != 14 || in_sizes[0] != MT * DM || out_size != MT * DM || ws_size < WS_END) {
        fprintf(stderr, "kernel_launch: unexpected shapes: n_in %d in0 %d out %d ws %zu (need %zu)\n", n_in, n_in > 0 ? in_sizes[0] : -1, out_size, ws_size, (size_t)WS_END);
        return; }
    static int grid = 0;
    if (!grid) {
        (void)hipFuncSetAttribute((const void*)k_convert, hipFuncAttributeMaxDynamicSharedMemorySize, 8 * 8448);
        (void)hipFuncSetAttribute((const void*)k_indexer_naive, hipFuncAttributeMaxDynamicSharedMemorySize, 8 * 8192);
        (void)hipFuncSetAttribute((const void*)k_attn_naive<0>, hipFuncAttributeMaxDynamicSharedMemorySize, 8 * 8704);
        (void)hipFuncSetAttribute((const void*)k_attn_naive<1>, hipFuncAttributeMaxDynamicSharedMemorySize, 8 * 8704);
        (void)hipFuncSetAttribute((const void*)k_attn_naive<2>, hipFuncAttributeMaxDynamicSharedMemorySize, 8 * 8704);
        (void)hipFuncSetAttribute((const void*)k_attn_naive<3>, hipFuncAttributeMaxDynamicSharedMemorySize, 8 * 8704);
        if (hipFuncSetAttribute((const void*)k_mega, hipFuncAttributeMaxDynamicSharedMemorySize, LDS_BYTES) != hipSuccess) fprintf(stderr, "kernel_launch: hipFuncSetAttribute(k_mega) failed\n");
        int dev = 0, cus = 0, per_cu = 0;
        (void)hipGetDevice(&dev); (void)hipDeviceGetAttribute(&cus, hipDeviceAttributeMultiprocessorCount, dev);
        if (hipOccupancyMaxActiveBlocksPerMultiprocessor(&per_cu, (const void*)k_mega, 512, LDS_BYTES) != hipSuccess || per_cu < 1)
            fprintf(stderr, "kernel_launch: occupancy query reports %d blocks per CU for k_mega\n", per_cu);
        (void)hipGetLastError();
        grid = cus > 0 ? cus : 256;
    }
    unsigned char* ws = (unsigned char*)d_ws;
    MegaArgs base{};
    for (int i = 0; i < 14; ++i) base.in[i] = (const float*)d_in[i];
    base.out = (float*)d_out; base.ws = ws; base.st_lo = 0; base.st_hi = 0;
    if ((FAST_MASK & F_ALL) == F_ALL) { launch_mega(stream, base, 0, N_STEPS, grid, d_ws); return; }

    const float* x = (const float*)d_in[0]; const float* mem = (const float*)d_in[1]; const float* ln_g = (const float*)d_in[2]; const float* ln_b = (const float*)d_in[3];
    const float* ffn_in = (const float*)d_in[4]; const float* ffn_out = (const float*)d_in[5]; const float* xq = (const float*)d_in[6]; const float* xkv = (const float*)d_in[7];
    const float* xo = (const float*)d_in[8]; const float* even_in = (const float*)d_in[9]; const float* even_out = (const float*)d_in[10]; const float* relb = (const float*)d_in[11];
    const float* odd_in = (const float*)d_in[12]; const float* odd_out = (const float*)d_in[13];
    float* X = (float*)(ws + WS_X); bf16_t* XB = (bf16_t*)(ws + WS_XB); float* Y = (float*)(ws + WS_Y); bf16_t* H = (bf16_t*)(ws + WS_H);
    bf16_t* QKV = (bf16_t*)(ws + WS_QKV); bf16_t* O = (bf16_t*)(ws + WS_O); bf16_t* XQ = (bf16_t*)(ws + WS_XQ); bf16_t* XO = (bf16_t*)(ws + WS_XO);
    bf16_t* KVX = (bf16_t*)(ws + WS_KVX); bf16_t* MEMB = (bf16_t*)(ws + WS_MEMB); float* SC = (float*)(ws + WS_SCORES); u64* MASK = (u64*)(ws + WS_MASK);
    float* C = (float*)(ws + WS_C); f32x2* T128 = (f32x2*)(ws + WS_ROPE128); f32x2* T64 = (f32x2*)(ws + WS_ROPE64);
    for (int lj = 0; lj < 8; ++lj) launch_convert(stream, ffn_in + (size_t)lj * DM * 2 * FFN, 2 * FFN, 2 * FFN, DM, (bf16_t*)(ws + WS_WN_FFN_IN + lj * SZ_FFN_IN), 2 * FFN / 32, 0);
    for (int i = 0; i < 2; ++i) launch_convert(stream, even_in + (size_t)i * DM * EVEN_COLS, EVEN_COLS, EVEN_COLS, DM, (bf16_t*)(ws + WS_WN_EVEN_IN + i * SZ_WN_EVEN_IN), 5472 / 32, 0);
    int st = 0;
    while (st < N_STEPS) {
        StepInfo si = step_info(st);
        if (!si.valid) { ++st; continue; }
        if (FAST_MASK & si.flag) {
            int e = st + 1;
            while (e < N_STEPS) { StepInfo s2 = step_info(e); if (s2.valid && !(FAST_MASK & s2.flag)) break; ++e; }
            launch_mega(stream, base, st, e, grid, d_ws); st = e; continue;
        }
        const int l = si.l, kind = si.kind, i = l / 2;
        switch (si.flag) {
        case F_PROLOGUE: {
            for (int lj = 0; lj < 8; ++lj) {
                launch_convert(stream, ffn_in + (size_t)lj * DM * 2 * FFN, 2 * FFN, 2 * FFN, DM, (bf16_t*)(ws + WS_WF_FFN_IN + lj * SZ_FFN_IN), 2 * FFN / 32, 1);
                launch_convert(stream, ffn_out + (size_t)lj * FFN * DM, DM, DM, FFN, (bf16_t*)(ws + WS_W_FFN_OUT + lj * SZ_FFN_OUT), DM / 32, 0); }
            for (int ii = 0; ii < 2; ++ii) {
                launch_convert(stream, even_in + (size_t)ii * DM * EVEN_COLS, EVEN_COLS, EVEN_COLS, DM, (bf16_t*)(ws + WS_WF_EVEN_IN + ii * SZ_EVEN_IN), EVP / 32, 2);
                launch_convert(stream, odd_in + (size_t)ii * DM * ODD_COLS, ODD_COLS, ODD_COLS, DM, (bf16_t*)(ws + WS_W_ODD_IN + ii * SZ_ODD_IN), ODD_COLS / 32, 0);
                launch_convert(stream, even_out + (size_t)ii * DM * DM, DM, DM, DM, (bf16_t*)(ws + WS_W_MIX_OUT + (2 * ii) * SZ_MIX_OUT), DM / 32, 0);
                launch_convert(stream, odd_out + (size_t)ii * DM * DM, DM, DM, DM, (bf16_t*)(ws + WS_W_MIX_OUT + (2 * ii + 1) * SZ_MIX_OUT), DM / 32, 0); }
            for (int ll = 0; ll < DEPTH; ++ll) {
                launch_convert(stream, xq + (size_t)ll * DM * 512, 512, 512, DM, (bf16_t*)(ws + WS_W_XQ + ll * SZ_XQ), 512 / 32, 0);
                launch_convert(stream, xkv + (size_t)ll * DM * 1024, 1024, 1024, DM, (bf16_t*)(ws + WS_W_XKV + ll * SZ_XKV), 1024 / 32, 0);
                launch_convert(stream, xo + (size_t)ll * 512 * DM, DM, DM, 512, (bf16_t*)(ws + WS_W_XO + ll * SZ_XO), DM / 32, 0); }
            hipLaunchKernelGGL(k_rope_tables, dim3((SEQ * 96 + 255) / 256), dim3(256), 0, stream, T128, T64);
            hipLaunchKernelGGL(k_cvt_x, dim3(2048), dim3(256), 0, stream, x, X, XB, (size_t)MT * DM / 4);
            hipLaunchKernelGGL(k_cvt_x, dim3(1024), dim3(256), 0, stream, mem, (float*)nullptr, MEMB, (size_t)NB * MEML * DM / 4);
        } break;
        case F_KVX:
            launch_gemm(stream, MEMB, DM, (const bf16_t*)(ws + WS_W_XKV), DM, C, 4096, NB * MEML, 4096, DM);
            hipLaunchKernelGGL(k_tobf, dim3(2048), dim3(256), 0, stream, C, KVX, (size_t)1024 * 4096);
            break;
        case F_FFN_IN: { const int lj = l * 2 + (kind == 3 ? 1 : 0);
            launch_gemm(stream, XB, DM, (const bf16_t*)(ws + WS_WN_FFN_IN + lj * SZ_FFN_IN), DM, C, 2 * FFN, MT, 2 * FFN, DM);
            hipLaunchKernelGGL(k_swiglu, dim3(4096), dim3(256), 0, stream, C, H); } break;
        case F_EV_IN:
            launch_gemm(stream, XB, DM, (const bf16_t*)(ws + WS_WN_EVEN_IN + i * SZ_WN_EVEN_IN), DM, C, EVEN_COLS, MT, EVEN_COLS, DM);
            hipLaunchKernelGGL(k_even_split, dim3(4096), dim3(256), 0, stream, C, QKV, T128, T64);
            break;
        case F_IDXBAND: {
            hipLaunchKernelGGL(k_indexer_naive, dim3(1024), dim3(512), 8 * 8192, stream, QKV, SC);
            AttnArgs b2{}; b2.Q = QKV; b2.K = QKV; b2.V = QKV; b2.O = O; b2.bias = relb + (size_t)i * 8 * RELSZ; b2.mask = nullptr;
            b2.ldq = EVP; b2.qoff = EV_QB; b2.ldk = EVP; b2.koff = EV_KB; b2.ldv = EVP; b2.voff = EV_VB; b2.ldo = DM; b2.ooff = 1024; b2.nheads = 8; b2.kvshared = 0;
            hipLaunchKernelGGL(k_attn_naive<1>, dim3(512), dim3(512), 8 * 8704, stream, b2); } break;
        case F_SELECT:
            hipLaunchKernelGGL(k_select, dim3(1024), dim3(512), 0, stream, SC, MASK);
            break;
        case F_DSA: {
            AttnArgs a{}; a.Q = QKV; a.K = QKV; a.V = QKV; a.O = O; a.bias = nullptr; a.mask = MASK;
            a.ldq = EVP; a.qoff = EV_QA; a.ldk = EVP; a.koff = EV_KA; a.ldv = EVP; a.voff = EV_VA; a.ldo = DM; a.ooff = 0; a.nheads = 8; a.kvshared = 1;
            hipLaunchKernelGGL(k_attn_naive<2>, dim3(512), dim3(512), 8 * 8704, stream, a); } break;
        case F_OD_IN:
            launch_gemm(stream, XB, DM, (const bf16_t*)(ws + WS_W_ODD_IN + i * SZ_ODD_IN), DM, C, ODD_COLS, MT, ODD_COLS, DM);
            hipLaunchKernelGGL(k_tobf, dim3(4096), dim3(256), 0, stream, C, QKV, (size_t)MT * ODD_COLS);
            break;
        case F_STICK: {
            AttnArgs a{}; a.Q = QKV; a.K = QKV; a.V = QKV; a.O = O; a.bias = nullptr; a.mask = nullptr;
            a.ldq = ODD_COLS; a.qoff = 0; a.ldk = ODD_COLS; a.koff = 2048; a.ldv = ODD_COLS; a.voff = 4096; a.ldo = DM; a.ooff = 0; a.nheads = 16; a.kvshared = 0;
            hipLaunchKernelGGL(k_attn_naive<3>, dim3(512), dim3(512), 8 * 8704, stream, a); } break;
        case F_XQ:
            launch_gemm(stream, XB, DM, (const bf16_t*)(ws + WS_W_XQ + l * SZ_XQ), DM, C, 512, MT, 512, DM);
            hipLaunchKernelGGL(k_tobf, dim3(2048), dim3(256), 0, stream, C, XQ, (size_t)MT * 512);
            break;
        case F_XATT: {
            AttnArgs a{}; a.Q = XQ; a.K = KVX; a.V = KVX; a.O = XO; a.bias = nullptr; a.mask = nullptr;
            a.ldq = 512; a.qoff = 0; a.ldk = 4096; a.koff = l * 1024; a.ldv = 4096; a.voff = l * 1024 + 512; a.ldo = 512; a.ooff = 0; a.nheads = 4; a.kvshared = 0;
            hipLaunchKernelGGL(k_attn_naive<0>, dim3(512), dim3(512), 8 * 8704, stream, a); } break;
        case F_OUT: {
            const bf16_t* oA; const bf16_t* oB; int oK; float ocs;
            if (kind == 0 || kind == 3) { const int lj = l * 2 + (kind == 3 ? 1 : 0); oA = H; oB = (const bf16_t*)(ws + WS_W_FFN_OUT + lj * SZ_FFN_OUT); oK = FFN; ocs = 0.5f; }
            else if (kind == 1) { oA = O; oB = (const bf16_t*)(ws + WS_W_MIX_OUT + l * SZ_MIX_OUT); oK = DM; ocs = 1.f; }
            else { oA = XO; oB = (const bf16_t*)(ws + WS_W_XO + l * SZ_XO); oK = 512; ocs = 1.f; }
            launch_gemm(stream, oA, oK, oB, oK, C, DM, MT, DM, oK);
            hipLaunchKernelGGL(k_resid, dim3(4096), dim3(256), 0, stream, C, X, Y, ocs); } break;
        case F_LN:
            hipLaunchKernelGGL(k_ln, dim3(1024), dim3(512), 0, stream, Y, ln_g + (size_t)(l * 4 + kind) * DM, ln_b + (size_t)(l * 4 + kind) * DM, X, XB, si.sb == 15 ? (float*)d_out : (float*)nullptr);
            break;
        }
        ++st;
    }
    const hipError_t le = hipPeekAtLastError();
    if (le != hipSuccess) fprintf(stderr, "kernel_launch: launch failed: %s\n", hipGetErrorName(le));
}
```

```cpp
#include <hip/hip_runtime.h>
#include <cstdio>
#include <cstdint>

#define DEVI __device__ __forceinline__
#define LAS __attribute__((address_space(3)))
typedef unsigned short bf16_t;
typedef short bf16x8 __attribute__((ext_vector_type(8)));
typedef float f32x4 __attribute__((ext_vector_type(4)));
typedef float f32x2 __attribute__((ext_vector_type(2)));
typedef unsigned u32x4 __attribute__((ext_vector_type(4)));
typedef unsigned u32x2 __attribute__((ext_vector_type(2)));
typedef unsigned long long u64;

constexpr int DM = 2048, NB = 4, SEQ = 2048, MT = NB * SEQ, DEPTH = 4, FFN = 5632, HD = 128, MEML = 256;
constexpr int EVEN_COLS = 5456, EVP = 5632, ODD_COLS = 6144, RELSZ = 192;
constexpr float ALPHA = 1.681792830507429f;
constexpr float SCALE = 0.08838834764831845f;
constexpr float LN_EPS = 1e-5f;
constexpr int EV_QA = 0, EV_KA = 1024, EV_VA = 1152, EV_QI = 1280, EV_KI = 2304, EV_WI = 2368, EV_QB = 2560, EV_KB = 3584, EV_VB = 4608;

constexpr size_t MiB = 1ull << 20;
constexpr size_t WS_CTL = 0;
constexpr size_t WS_ROPE128 = 1 * MiB;
constexpr size_t WS_ROPE64 = 2 * MiB;
constexpr size_t WS_WF_FFN_IN = 3 * MiB;
constexpr size_t SZ_FFN_IN = (size_t)2 * FFN * DM * 2;
constexpr size_t WS_W_FFN_OUT = WS_WF_FFN_IN + 8 * SZ_FFN_IN;
constexpr size_t SZ_FFN_OUT = (size_t)DM * FFN * 2;
constexpr size_t WS_WF_EVEN_IN = WS_W_FFN_OUT + 8 * SZ_FFN_OUT;
constexpr size_t SZ_EVEN_IN = (size_t)EVP * DM * 2;
constexpr size_t WS_W_ODD_IN = WS_WF_EVEN_IN + 2 * SZ_EVEN_IN;
constexpr size_t SZ_ODD_IN = (size_t)ODD_COLS * DM * 2;
constexpr size_t WS_W_MIX_OUT = WS_W_ODD_IN + 2 * SZ_ODD_IN;
constexpr size_t SZ_MIX_OUT = (size_t)DM * DM * 2;
constexpr size_t WS_W_XQ = WS_W_MIX_OUT + 4 * SZ_MIX_OUT;
constexpr size_t SZ_XQ = (size_t)512 * DM * 2;
constexpr size_t WS_W_XKV = WS_W_XQ + 4 * SZ_XQ;
constexpr size_t SZ_XKV = (size_t)1024 * DM * 2;
constexpr size_t WS_W_XO = WS_W_XKV + 4 * SZ_XKV;
constexpr size_t SZ_XO = (size_t)DM * 512 * 2;
constexpr size_t WS_WN_FFN_IN = WS_W_XO + 4 * SZ_XO;
constexpr size_t WS_WN_EVEN_IN = WS_WN_FFN_IN + 8 * SZ_FFN_IN;
constexpr size_t SZ_WN_EVEN_IN = (size_t)5472 * DM * 2;
constexpr size_t WS_X = ((WS_WN_EVEN_IN + 2 * SZ_WN_EVEN_IN + MiB - 1) / MiB) * MiB;
constexpr size_t WS_XB = WS_X + 64 * MiB;
constexpr size_t WS_Y = WS_XB + 32 * MiB;
constexpr size_t WS_H = WS_Y + 64 * MiB;
constexpr size_t WS_QKV = WS_H + 88 * MiB;
constexpr size_t WS_O = WS_QKV + 96 * MiB;
constexpr size_t WS_XQ = WS_O + 32 * MiB;
constexpr size_t WS_XO = WS_XQ + 8 * MiB;
constexpr size_t WS_KVX = WS_XO + 8 * MiB;
constexpr size_t WS_MEMB = WS_KVX + 8 * MiB;
constexpr size_t WS_SCORES = WS_MEMB + 4 * MiB;
constexpr size_t WS_MASK = WS_SCORES + 64 * MiB;
constexpr size_t WS_C = WS_MASK + 2 * MiB;
constexpr size_t WS_END = WS_C + 352 * MiB;

DEVI float bf2f(bf16_t v) { return __uint_as_float(((unsigned)v) << 16); }
DEVI unsigned f2bf(float f) { unsigned u = __float_as_uint(f); return (u + 0x7fffu + ((u >> 16) & 1u)) >> 16; }
DEVI unsigned pk2(float lo, float hi) { return f2bf(lo) | (f2bf(hi) << 16); }
DEVI float wave_sum(float v) {
#pragma unroll
    for (int o = 32; o >= 1; o >>= 1) v += __shfl_xor(v, o);
    return v;
}
DEVI float wave_max(float v) {
#pragma unroll
    for (int o = 32; o >= 1; o >>= 1) v = fmaxf(v, __shfl_xor(v, o));
    return v;
}

DEVI void map_group(int mode, int dg, int nsrc, int& s0, int& nv) {
    nv = 32;
    if (mode == 0) { s0 = 32 * dg; int rem = nsrc - s0; nv = rem < 0 ? 0 : (rem > 32 ? 32 : rem); }
    else if (mode == 1) { const int pn = dg >> 3, r = (dg & 7) * 32; s0 = (r < 128) ? pn * 128 + r : FFN + pn * 128 + (r - 128); }
    else {
        const int pn = dg >> 3, q = dg & 7, bj = q >> 2, j = (q & 3) * 32;
        if (pn < 4) { const int g = j >> 6; s0 = pn * 256 + g * 128 + bj * 64 + (j & 63); }
        else if (pn == 4) { const int g = j >> 6; s0 = 1024 + g * 128 + bj * 64 + (j & 63); }
        else if (pn < 9) { const int g = j >> 5; s0 = 1280 + (pn - 5) * 256 + g * 64 + bj * 32; }
        else if (pn == 9) { const int g = j >> 5; if (g == 0) s0 = 2304 + bj * 32; else if (g == 1 && bj == 0) { s0 = 2368; nv = 16; } else { s0 = 0; nv = 0; } }
        else { s0 = 2384 + (pn - 10) * 256 + q * 32; }
    }
}
DEVI void transpose_item(const float* W, int ldw, int s0, int nv, bf16_t* WT, int K, int drow0, int k0, LAS float* scr, int lane) {
#pragma unroll 8
    for (int i = 0; i < 32; ++i) { const int kk = 2 * i + (lane >> 5); const int c = lane & 31;
        scr[kk * 33 + c] = (c < nv) ? W[(size_t)(k0 + kk) * ldw + s0 + c] : 0.f; }
    asm volatile("s_waitcnt lgkmcnt(0)" ::: "memory");
    const int c = lane & 7;
#pragma unroll
    for (int j = 0; j < 4; ++j) { const int n = (lane >> 3) + 8 * j; const LAS float* s = scr + (8 * c) * 33 + n;
        u32x4 o; o.x = pk2(s[0 * 33], s[1 * 33]); o.y = pk2(s[2 * 33], s[3 * 33]); o.z = pk2(s[4 * 33], s[5 * 33]); o.w = pk2(s[6 * 33], s[7 * 33]);
        *(u32x4*)(WT + (size_t)(drow0 + n) * K + k0 + 8 * c) = o; }
    asm volatile("s_waitcnt lgkmcnt(0)" ::: "memory");
}
DEVI void convert_matrix(const float* W, int ldw, int nsrc, int K, bf16_t* WT, int ngroups, int mode, int gw, int ngw, LAS float* scr, int lane) {
    const int nkb = K / 64, nitems = ngroups * nkb;
    for (int it = gw; it < nitems; it += ngw) {
        const int dg = it / nkb, kb = it % nkb; int s0, nv; map_group(mode, dg, nsrc, s0, nv);
        transpose_item(W, ldw, s0, nv, WT, K, dg * 32, kb * 64, scr, lane);
    }
}
__global__ __launch_bounds__(512) void k_convert(const float* W, int ldw, int nsrc, int K, bf16_t* WT, int ngroups, int mode) {
    extern __shared__ __attribute__((aligned(16))) unsigned char dyn_lds[];
    const int wave = threadIdx.x >> 6, lane = threadIdx.x & 63;
    LAS float* scr = (LAS float*)((LAS unsigned char*)dyn_lds + wave * 8448);
    convert_matrix(W, ldw, nsrc, K, WT, ngroups, mode, blockIdx.x * 8 + wave, gridDim.x * 8, scr, lane);
}

__global__ __launch_bounds__(256) void k_rope_tables(f32x2* t128, f32x2* t64) {
    const int i = blockIdx.x * 256 + threadIdx.x;
    if (i < SEQ * 96) {
        const int pos = i / 96, f = i % 96; const bool big = f < 64; const int ff = big ? f : f - 64; const double half = big ? 64.0 : 32.0;
        const double inv = exp2(-(double)ff / half * 13.287712379549449);
        const double rev = (double)pos * inv * 0.15915494309189535; const double fr = rev - rint(rev);
        const float c = __builtin_amdgcn_cosf((float)fr), s = __builtin_amdgcn_sinf((float)fr);
        if (big) t128[pos * 64 + ff] = (f32x2){c, s}; else t64[pos * 32 + ff] = (f32x2){c, s};
    }
}
__global__ __launch_bounds__(256) void k_cvt_x(const float* x, float* X, bf16_t* XB, size_t n4) {
    for (size_t i = blockIdx.x * 256ull + threadIdx.x; i < n4; i += gridDim.x * 256ull) {
        const f32x4 v = ((const f32x4*)x)[i]; if (X) ((f32x4*)X)[i] = v;
        u32x2 o; o.x = pk2(v.x, v.y); o.y = pk2(v.z, v.w); ((u32x2*)XB)[i] = o; }
}

__global__ __launch_bounds__(512) void k_gemm_naive(const bf16_t* A, int lda, const bf16_t* Bt, int ldb, float* C, int ldc, int M, int N, int K) {
    const int gw = blockIdx.x * 8 + (threadIdx.x >> 6), ngw = gridDim.x * 8, lane = threadIdx.x & 63;
    const int ntn = N / 16, ntm = M / 32;
    for (int t = gw; t < ntm * ntn; t += ngw) {
        const int tm = t / ntn, tn = t % ntn;
        const bf16_t* a0 = A + (size_t)(tm * 32 + (lane & 15)) * lda + 8 * (lane >> 4);
        const bf16_t* a1 = a0 + (size_t)16 * lda;
        const bf16_t* b = Bt + (size_t)(tn * 16 + (lane & 15)) * ldb + 8 * (lane >> 4);
        f32x4 c0 = {0.f, 0.f, 0.f, 0.f}, c1 = {0.f, 0.f, 0.f, 0.f};
#pragma unroll 4
        for (int k = 0; k < K; k += 32) {
            const bf16x8 fa0 = *(const bf16x8*)(a0 + k), fa1 = *(const bf16x8*)(a1 + k), fb = *(const bf16x8*)(b + k);
            c0 = __builtin_amdgcn_mfma_f32_16x16x32_bf16(fa0, fb, c0, 0, 0, 0);
            c1 = __builtin_amdgcn_mfma_f32_16x16x32_bf16(fa1, fb, c1, 0, 0, 0);
        }
#pragma unroll
        for (int r = 0; r < 4; ++r) {
            C[(size_t)(tm * 32 + (lane >> 4) * 4 + r) * ldc + tn * 16 + (lane & 15)] = c0[r];
            C[(size_t)(tm * 32 + 16 + (lane >> 4) * 4 + r) * ldc + tn * 16 + (lane & 15)] = c1[r];
        }
    }
}

__global__ __launch_bounds__(256) void k_swiglu(const float* C, bf16_t* H) {
    for (size_t i = blockIdx.x * 256ull + threadIdx.x; i < (size_t)MT * FFN; i += gridDim.x * 256ull) {
        const size_t m = i / FFN, j = i % FFN; const float a = C[m * 2 * FFN + j], g = C[m * 2 * FFN + FFN + j];
        H[i] = (bf16_t)f2bf(a / (1.f + expf(-a)) * g); }
}
__global__ __launch_bounds__(256) void k_resid(const float* C, const float* X, float* Y, float cscale) {
    for (size_t i = blockIdx.x * 256ull + threadIdx.x; i < (size_t)MT * DM; i += gridDim.x * 256ull) Y[i] = ALPHA * X[i] + cscale * C[i];
}
__global__ __launch_bounds__(256) void k_tobf(const float* C, bf16_t* O, size_t n) {
    for (size_t i = blockIdx.x * 256ull + threadIdx.x; i < n; i += gridDim.x * 256ull) O[i] = (bf16_t)f2bf(C[i]);
}
DEVI void ln_row(const float* y, const float* g, const float* b, float* x, bf16_t* xb, float* out, int lane) {
    f32x4 v[8]; float s = 0.f;
#pragma unroll
    for (int j = 0; j < 8; ++j) { v[j] = ((const f32x4*)y)[lane + 64 * j]; s += (v[j].x + v[j].y) + (v[j].z + v[j].w); }
    const float mean = wave_sum(s) * (1.f / DM); float s2 = 0.f;
#pragma unroll
    for (int j = 0; j < 8; ++j) { v[j] = v[j] - mean; s2 += (v[j].x * v[j].x + v[j].y * v[j].y) + (v[j].z * v[j].z + v[j].w * v[j].w); }
    const float rstd = 1.f / sqrtf(wave_sum(s2) * (1.f / DM) + LN_EPS);
#pragma unroll
    for (int j = 0; j < 8; ++j) { const f32x4 gg = ((const f32x4*)g)[lane + 64 * j], bb = ((const f32x4*)b)[lane + 64 * j];
        const f32x4 o = v[j] * rstd * gg + bb; ((f32x4*)x)[lane + 64 * j] = o; if (out) ((f32x4*)out)[lane + 64 * j] = o;
        u32x2 w; w.x = pk2(o.x, o.y); w.y = pk2(o.z, o.w); ((u32x2*)xb)[lane + 64 * j] = w; }
}
__global__ __launch_bounds__(512) void k_ln(const float* Y, const float* g, const float* b, float* X, bf16_t* XB, float* OUT) {
    const int gw = blockIdx.x * 8 + (threadIdx.x >> 6), ngw = gridDim.x * 8, lane = threadIdx.x & 63;
    for (int m = gw; m < MT; m += ngw) ln_row(Y + (size_t)m * DM, g, b, X + (size_t)m * DM, XB + (size_t)m * DM, OUT ? OUT + (size_t)m * DM : nullptr, lane);
}
__global__ __launch_bounds__(256) void k_even_split(const float* C, bf16_t* EV, const f32x2* t128, const f32x2* t64) {
    for (size_t i = blockIdx.x * 256ull + threadIdx.x; i < (size_t)MT * EVP; i += gridDim.x * 256ull) {
        const int m = (int)(i / EVP), dcol = (int)(i % EVP), pos = m % SEQ; const float* c = C + (size_t)m * EVEN_COLS;
        float v = 0.f;
        if (dcol < 2384) {
            const int s = dcol;
            if (s < 1152) {
                const int d = s & 127;
                if (d < 64) { const f32x2 cs = t128[pos * 64 + d]; v = c[s] * cs.x - c[s + 64] * cs.y; }
                else { const f32x2 cs = t128[pos * 64 + d - 64]; v = c[s] * cs.x + c[s - 64] * cs.y; }
            } else if (s < 1280) v = c[s];
            else if (s < 2368) {
                const int d = (s - 1280) & 63;
                if (d < 32) { const f32x2 cs = t64[pos * 32 + d]; v = c[s] * cs.x - c[s + 32] * cs.y; }
                else { const f32x2 cs = t64[pos * 32 + d - 32]; v = c[s] * cs.x + c[s - 32] * cs.y; }
            } else v = c[s];
        } else if (dcol >= 2560) v = c[dcol - 176];
        EV[i] = (bf16_t)f2bf(v);
    }
}

DEVI void indexer_naive_phase(const bf16_t* EV, float* SC, LAS unsigned char* lds, int wave, int lane, int gw, int ngw) {
    LAS float* qf = (LAS float*)(lds + wave * 8192);
    for (int m = gw; m < MT; m += ngw) {
        const int b = m / SEQ, t = m % SEQ, nk = (t / 64 + 1) * 64;
        const bf16_t* qrow = EV + (size_t)m * EVP + EV_QI;
        for (int i = lane; i < 1024; i += 64) qf[i] = bf2f(qrow[i]);
        if (lane < 16) qf[1024 + lane] = bf2f(EV[(size_t)m * EVP + EV_WI + lane]);
        asm volatile("s_waitcnt lgkmcnt(0)" ::: "memory");
        for (int s0 = 0; s0 < nk; s0 += 64) {
            const int s = s0 + lane; const bf16_t* krow = EV + (size_t)(b * SEQ + s) * EVP + EV_KI;
            float kf[64];
#pragma unroll
            for (int i = 0; i < 8; ++i) { const bf16x8 kv = *(const bf16x8*)(krow + 8 * i);
#pragma unroll
                for (int e = 0; e < 8; ++e) kf[8 * i + e] = bf2f((bf16_t)kv[e]); }
            float sc = 0.f;
#pragma unroll 1
            for (int h = 0; h < 16; ++h) { float d = 0.f;
#pragma unroll
                for (int e = 0; e < 64; ++e) d += qf[h * 64 + e] * kf[e];
                sc += qf[1024 + h] * fmaxf(d, 0.f); }
            SC[(size_t)m * SEQ + s] = sc;
        }
        asm volatile("s_waitcnt lgkmcnt(0)" ::: "memory");
    }
}
__global__ __launch_bounds__(512) void k_indexer_naive(const bf16_t* EV, float* SC) {
    extern __shared__ __attribute__((aligned(16))) unsigned char dyn_lds[];
    const int wave = threadIdx.x >> 6, lane = threadIdx.x & 63;
    indexer_naive_phase(EV, SC, (LAS unsigned char*)dyn_lds, wave, lane, blockIdx.x * 8 + wave, gridDim.x * 8);
}

DEVI unsigned ordkey(float f) { const unsigned u = __float_as_uint(f); return (u & 0x80000000u) ? ~u : (u | 0x80000000u); }
template <class MP> DEVI void select_row(const float* sc, int c  , MP mrow, int lane) {
    if (c < 4) { if (lane <= c) mrow[lane] = ~0ull; return; }
    unsigned u[32];
#pragma unroll
    for (int j = 0; j < 32; ++j) u[j] = (j <= c) ? ordkey(sc[64 * j + lane]) : 0u;
    unsigned T = 0u;
#pragma unroll 1
    for (int bit = 31; bit >= 0; --bit) {
        const unsigned cand = T | (1u << bit); int cnt = 0;
#pragma unroll
        for (int j = 0; j < 32; ++j) if (j <= c) cnt += __popcll(__ballot(u[j] >= cand));
        if (cnt >= 256) T = cand;
    }
    int ngt = 0;
#pragma unroll
    for (int j = 0; j < 32; ++j) if (j <= c) ngt += __popcll(__ballot(u[j] > T));
    int need = 256 - ngt;
#pragma unroll
    for (int j = 0; j < 32; ++j) if (j <= c) {
        const u64 gt = __ballot(u[j] > T); u64 eq = __ballot(u[j] == T);
        int ne = __popcll(eq); const int take = ne < need ? ne : need;
        while (ne > take) { eq &= ~(1ull << (63 - __clzll(eq))); --ne; }
        need -= take;
        if (lane == 0) mrow[j] = gt | eq;
    }
}
__global__ __launch_bounds__(512) void k_select(const float* SC, u64* MASK) {
    const int gw = blockIdx.x * 8 + (threadIdx.x >> 6), ngw = gridDim.x * 8, lane = threadIdx.x & 63;
    for (int m = gw; m < MT; m += ngw) select_row(SC + (size_t)m * SEQ, (m % SEQ) / 64, MASK + (size_t)m * 32, lane);
}

struct AttnArgs { const bf16_t* Q; const bf16_t* K; const bf16_t* V; bf16_t* O; const float* bias; const u64* mask;
                  int ldq, qoff, ldk, koff, ldv, voff, ldo, ooff, nheads, kvshared; };
DEVI float log_sigmoid(float z) { return fminf(z, 0.f) - log1pf(expf(-fabsf(z))); }
template <int MODE> DEVI void attn_naive_phase(const AttnArgs& a, LAS unsigned char* lds, int wave, int lane, int gw, int ngw) {
    LAS float* sc = (LAS float*)(lds + wave * 8704);
    const int ntask = MT * a.nheads;
    for (int task = gw; task < ntask; task += ngw) {
        const int m = task / a.nheads, h = task % a.nheads, b = m / SEQ, t = m % SEQ, c = t / 64, kh = a.kvshared ? 0 : h;
        int s_lo, s_hi, rowbase;
        if (MODE == 0) { s_lo = 0; s_hi = MEML; rowbase = b * MEML; }
        else if (MODE == 1) { s_lo = (c - 8) * 64; if (s_lo < 0) s_lo = 0; s_hi = (c + 1) * 64; rowbase = b * SEQ; }
        else if (MODE == 2) { s_lo = 0; s_hi = (c + 1) * 64; rowbase = b * SEQ; }
        else { s_lo = 0; s_hi = t; rowbase = b * SEQ; }
        const unsigned qq = *(const unsigned*)(a.Q + (size_t)m * a.ldq + a.qoff + h * HD + 2 * lane);
        const float q0 = bf2f((bf16_t)(qq & 0xffffu)), q1 = bf2f((bf16_t)(qq >> 16));
        const bf16_t* Kb = a.K + (size_t)rowbase * a.ldk + a.koff + kh * HD + 2 * lane;
        const bf16_t* Vb = a.V + (size_t)rowbase * a.ldv + a.voff + kh * HD + 2 * lane;
        for (int s = s_lo; s < s_hi; ++s) {
            bool sel = true;
            if (MODE == 2) sel = (a.mask[(size_t)m * 32 + (s >> 6)] >> (s & 63)) & 1ull;
            float z = -INFINITY;
            if (sel) { const unsigned kk = *(const unsigned*)(Kb + (size_t)s * a.ldk);
                z = wave_sum(q0 * bf2f((bf16_t)(kk & 0xffffu)) + q1 * bf2f((bf16_t)(kk >> 16))) * SCALE;
                if (MODE == 1) { int dist = t - s; dist = dist < -63 ? -63 : (dist > 128 ? 128 : dist); z += a.bias[h * RELSZ + dist + 63]; } }
            if (lane == 0) sc[s - s_lo] = z;
        }
        asm volatile("s_waitcnt lgkmcnt(0)" ::: "memory");
        const int n = s_hi - s_lo;
        if (MODE != 3) {
            float mx = -INFINITY; for (int i = lane; i < n; i += 64) mx = fmaxf(mx, sc[i]);
            mx = wave_max(mx);
            float sum = 0.f; for (int i = lane; i < n; i += 64) { const float p = expf(sc[i] - mx); sc[i] = p; sum += p; }
            sum = wave_sum(sum); const float inv = 1.f / sum;
            for (int i = lane; i < n; i += 64) sc[i] *= inv;
        } else {
            const int lo = 32 * lane, hi = (lo + 32 < n) ? lo + 32 : n;
            float cs = 0.f; for (int i = lo; i < hi; ++i) cs += log_sigmoid(-sc[i]);
            sc[2048 + lane] = cs;
            asm volatile("s_waitcnt lgkmcnt(0)" ::: "memory");
            float run = 0.f; for (int l2 = 63; l2 > lane; --l2) run += sc[2048 + l2];
            for (int i = hi - 1; i >= lo; --i) { const float z = sc[i]; sc[i] = expf(log_sigmoid(z) + run); run += log_sigmoid(-z); }
        }
        asm volatile("s_waitcnt lgkmcnt(0)" ::: "memory");
        float o0 = 0.f, o1 = 0.f;
        for (int s = s_lo; s < s_hi; ++s) { const float w = sc[s - s_lo];
            if (w != 0.f) { const unsigned vv = *(const unsigned*)(Vb + (size_t)s * a.ldv); o0 += w * bf2f((bf16_t)(vv & 0xffffu)); o1 += w * bf2f((bf16_t)(vv >> 16)); } }
        *(unsigned*)(a.O + (size_t)m * a.ldo + a.ooff + h * HD + 2 * lane) = pk2(o0, o1);
        asm volatile("s_waitcnt lgkmcnt(0)" ::: "memory");
    }
}
template <int MODE> __global__ __launch_bounds__(512) void k_attn_naive(AttnArgs a) {
    extern __shared__ __attribute__((aligned(16))) unsigned char dyn_lds[];
    const int wave = threadIdx.x >> 6, lane = threadIdx.x & 63;
    attn_naive_phase<MODE>(a, (LAS unsigned char*)dyn_lds, wave, lane, blockIdx.x * 8 + wave, gridDim.x * 8);
}


namespace pg8 {
#define PG8_LAS __attribute__((address_space(3)))
typedef unsigned short bf16_t;
typedef short bf16x8 __attribute__((ext_vector_type(8)));
typedef float f32x4 __attribute__((ext_vector_type(4)));
typedef unsigned u32x4 __attribute__((ext_vector_type(4)));
constexpr int BM = 256, BK = 64, HALF = 128, HTB = HALF * BK * 2  , STAGE_BYTES = 8 * HTB, NXCD = 8, WGM = 8;

__host__ __device__ __forceinline__ int lds_byte(int r, int c) { const int st = (r >> 4) * 2 + (c >> 5), rr = r & 15, cc = c & 31, ob = rr * 64 + cc * 2; return st * 1024 + (ob ^ (((ob >> 9) & 1) << 5)); }
__host__ __device__ __forceinline__ void stage_rc(int b, int& R, int& C) { const int st = b / 1024, sb = b % 1024, swz = sb ^ (((sb >> 9) & 1) << 5); R = (st >> 1) * 16 + swz / 64; C = (st & 1) * 32 + (swz % 64) / 2; }
__host__ __device__ __forceinline__ int perm32(int rho) { const int n = rho >> 4, i = rho & 15; return 8 * (i >> 2) + 4 * n + (i & 3); }

struct Unit { int pm, pn; };
struct Gemm { const bf16_t* A; const bf16_t* Bt; int M, N, K; };

struct StaticOrder {
    int nM, nN, nwg, G, c;
    __host__ __device__ void init(int M, int N, int G_, int c_) { nM = M / BM; nN = N / BM; nwg = nM * nN; G = G_; c = c_; }
    __host__ __device__ bool next(int i, Unit& u) const {
        const long L = (long)i * G + c; if (L >= nwg) return false;
        int wgid = (int)L; { const int q = nwg / NXCD, r = nwg % NXCD, xcd = wgid % NXCD, off = wgid / NXCD; wgid = (xcd < r ? xcd * (q + 1) : r * (q + 1) + (xcd - r) * q) + off; }
        const int nig = WGM * nN, gid = wgid / nig, fm = gid * WGM, gsz = (nM - fm) < WGM ? (nM - fm) : WGM;
        u.pm = fm + ((wgid % nig) % gsz); u.pn = (wgid % nig) / gsz; return true;
    }
    __device__ __forceinline__ void a_ready(const Unit&) const {}
    __device__ __forceinline__ void done(const Unit&) const {}
};

__device__ __forceinline__ unsigned cvt_pk_bf16(float lo, float hi) { unsigned r; asm volatile("v_cvt_pk_bf16_f32 %0, %1, %2" : "=v"(r) : "v"(lo), "v"(hi)); return r; }
struct EpiBf16 {
    static constexpr bool PERM = true, AFTER_DRAIN = false;
    bf16_t* O; int ldc;
    __device__ __forceinline__ void operator()(const f32x4 (&acc)[2][2][4][2], const Unit& u, int wr, int wc, int fr, int fq) const {
        const int row0 = u.pm * BM + wr * 64 + fr, col0 = u.pn * BM + wc * 32 + 8 * fq;
#pragma unroll
        for (int ai = 0; ai < 2; ++ai)
#pragma unroll
            for (int m = 0; m < 4; ++m) { bf16_t* rowp = O + (size_t)(row0 + ai * HALF + m * 16) * ldc + col0;
#pragma unroll
                for (int bj = 0; bj < 2; ++bj) { const f32x4 v0 = acc[ai][bj][m][0], v1 = acc[ai][bj][m][1];
                    u32x4 w; w.x = cvt_pk_bf16(v0[0], v0[1]); w.y = cvt_pk_bf16(v0[2], v0[3]); w.z = cvt_pk_bf16(v1[0], v1[1]); w.w = cvt_pk_bf16(v1[2], v1[3]);
                    *(u32x4*)(rowp + bj * HALF) = w; } }
    }
};
struct EpiSwiglu {
    static constexpr bool PERM = true, AFTER_DRAIN = false;
    bf16_t* H; int ldc;
    static __device__ __forceinline__ float sg(float a, float g) { return a * __builtin_amdgcn_rcpf(1.f + __builtin_amdgcn_exp2f(-1.4426950408889634f * a)) * g; }
    __device__ __forceinline__ void operator()(const f32x4 (&acc)[2][2][4][2], const Unit& u, int wr, int wc, int fr, int fq) const {
        const int row0 = u.pm * BM + wr * 64 + fr, col0 = u.pn * HALF + wc * 32 + 8 * fq;
#pragma unroll
        for (int ai = 0; ai < 2; ++ai)
#pragma unroll
            for (int m = 0; m < 4; ++m) { bf16_t* rowp = H + (size_t)(row0 + ai * HALF + m * 16) * ldc + col0;
                const f32x4 a0 = acc[ai][0][m][0], a1 = acc[ai][0][m][1], g0 = acc[ai][1][m][0], g1 = acc[ai][1][m][1];
                u32x4 w; w.x = cvt_pk_bf16(sg(a0[0], g0[0]), sg(a0[1], g0[1])); w.y = cvt_pk_bf16(sg(a0[2], g0[2]), sg(a0[3], g0[3]));
                w.z = cvt_pk_bf16(sg(a1[0], g1[0]), sg(a1[1], g1[1])); w.w = cvt_pk_bf16(sg(a1[2], g1[2]), sg(a1[3], g1[3]));
                *(u32x4*)rowp = w; }
    }
};
struct EpiRope {
    static constexpr bool PERM = true, AFTER_DRAIN = false;
    bf16_t* EV; int ldc; const f32x2* t128; const f32x2* t64; int seq;
    __device__ __forceinline__ void operator()(const f32x4 (&acc)[2][2][4][2], const Unit& u, int wr, int wc, int fr, int fq) const {
        const int row0 = u.pm * BM + wr * 64 + fr, jj = wc * 32 + 8 * fq, pn = u.pn;
        if (pn >= 10) {
#pragma unroll
            for (int ai = 0; ai < 2; ++ai)
#pragma unroll
                for (int m = 0; m < 4; ++m) { bf16_t* rowp = EV + (size_t)(row0 + ai * HALF + m * 16) * ldc + pn * BM + jj;
#pragma unroll
                    for (int bj = 0; bj < 2; ++bj) { const f32x4 v0 = acc[ai][bj][m][0], v1 = acc[ai][bj][m][1];
                        u32x4 w; w.x = cvt_pk_bf16(v0[0], v0[1]); w.y = cvt_pk_bf16(v0[2], v0[3]); w.z = cvt_pk_bf16(v1[0], v1[1]); w.w = cvt_pk_bf16(v1[2], v1[3]);
                        *(u32x4*)(rowp + bj * HALF) = w; } }
        } else {
            const bool big = pn < 5; const int hw = big ? 64 : 32, g = big ? (jj >> 6) : (jj >> 5), dd = jj & (hw - 1);
            const bool dorope = (pn == 4 || pn == 9) ? (g == 0) : true;
            const f32x2* tab = big ? t128 : t64;
#pragma unroll
            for (int ai = 0; ai < 2; ++ai)
#pragma unroll
                for (int m = 0; m < 4; ++m) { const int row = row0 + ai * HALF + m * 16, pos = row % seq;
                    const f32x4* tp = (const f32x4*)(tab + (size_t)pos * hw + dd);
                    f32x4 cs[4];
#pragma unroll
                    for (int e = 0; e < 4; ++e) cs[e] = dorope ? tp[e] : (f32x4){1.f, 0.f, 1.f, 0.f};
                    float o1[8], o2[8];
#pragma unroll
                    for (int e = 0; e < 8; ++e) { const float x1 = acc[ai][0][m][e >> 2][e & 3], x2 = acc[ai][1][m][e >> 2][e & 3];
                        const float c = (e & 1) ? cs[e >> 1][2] : cs[e >> 1][0], s = (e & 1) ? cs[e >> 1][3] : cs[e >> 1][1];
                        o1[e] = x1 * c - x2 * s; o2[e] = x2 * c + x1 * s; }
                    bf16_t* rowp = EV + (size_t)row * ldc + pn * BM + g * 2 * hw + dd;
                    u32x4 w1, w2; w1.x = cvt_pk_bf16(o1[0], o1[1]); w1.y = cvt_pk_bf16(o1[2], o1[3]); w1.z = cvt_pk_bf16(o1[4], o1[5]); w1.w = cvt_pk_bf16(o1[6], o1[7]);
                    w2.x = cvt_pk_bf16(o2[0], o2[1]); w2.y = cvt_pk_bf16(o2[2], o2[3]); w2.z = cvt_pk_bf16(o2[4], o2[5]); w2.w = cvt_pk_bf16(o2[6], o2[7]);
                    *(u32x4*)rowp = w1; *(u32x4*)(rowp + hw) = w2; }
        }
    }
};
struct EpiResid {
    static constexpr bool PERM = false, AFTER_DRAIN = false;
    const float* X; float* Y; int ldc; float alpha, cs;
    __device__ __forceinline__ void operator()(const f32x4 (&acc)[2][2][4][2], const Unit& u, int wr, int wc, int fr, int fq) const {
        const int col0 = u.pn * BM + wc * 32 + 4 * fq;
#pragma unroll
        for (int ai = 0; ai < 2; ++ai)
#pragma unroll
            for (int m = 0; m < 4; ++m) { const size_t off = (size_t)(u.pm * BM + ai * HALF + wr * 64 + m * 16 + fr) * ldc + col0;
#pragma unroll
                for (int bj = 0; bj < 2; ++bj)
#pragma unroll
                    for (int n = 0; n < 2; ++n) { const f32x4 xv = *(const f32x4*)(X + off + bj * HALF + n * 16);
                        *(f32x4*)(Y + off + bj * HALF + n * 16) = xv * alpha + acc[ai][bj][m][n] * cs; } }
    }
};

template <class Epi, class Sched, bool ALIGN_EPI = false, bool SP2 = false>
__device__ __forceinline__ void gemm_phase(PG8_LAS unsigned char* lds, const Gemm g, const Sched& S, const Epi& E) {
    int tid_ = threadIdx.x; asm volatile("" : "+v"(tid_));
    const int tid = tid_, wid = __builtin_amdgcn_readfirstlane(tid >> 6), lane = tid & 63, wr = wid >> 2, wc = wid & 3, fr = lane & 15, fq = lane >> 4;
    const int K = g.K, nt = K / BK;
    unsigned voffA[2], voffB[2];
#pragma unroll
    for (int i = 0; i < 2; ++i) { int R, C; stage_rc(tid * 16 + i * 8192, R, C); const int Rb = Epi::PERM ? ((R & ~31) + perm32(R & 31)) : R;
        voffA[i] = (unsigned)(R * K + C) * 2u; voffB[i] = (unsigned)(Rb * K + C) * 2u; }
    const size_t kstep = (size_t)(BK * 2);
    const size_t hstep = (size_t)HALF * K * 2;
    const size_t tstep = 2 * hstep;
    const unsigned ldsw = (unsigned)wid * 1024u;
    const int aoff = lds_byte(wr * 64 + fr, fq * 8), boff = lds_byte(wc * 32 + fr, fq * 8);
#define PG8_SA(b, h) (((b) * 2 + (h)) * HTB)
#define PG8_SB(b, h) ((4 + (b) * 2 + (h)) * HTB)
#define PG8_STAGE(bufoff, gbase, voff) do { _Pragma("unroll") for (int _i = 0; _i < 2; ++_i) \
        __builtin_amdgcn_global_load_lds((const unsigned*)((const char*)(gbase) + (voff)[_i]), (PG8_LAS unsigned*)(lds + (bufoff) + ldsw + _i * 8192), 16, 0, 0); } while (0)
#define PG8_LDA(dst, b, h) do { _Pragma("unroll") for (int m = 0; m < 4; ++m) _Pragma("unroll") for (int k = 0; k < 2; ++k) dst[m][k] = *(const PG8_LAS bf16x8*)(lds + PG8_SA(b, h) + aoff + m * 2048 + k * 1024); } while (0)
#define PG8_LDB(dst, b, h) do { _Pragma("unroll") for (int n = 0; n < 2; ++n) _Pragma("unroll") for (int k = 0; k < 2; ++k) dst[n][k] = *(const PG8_LAS bf16x8*)(lds + PG8_SB(b, h) + boff + n * 2048 + k * 1024); } while (0)
#define PG8_MMA(ai, bj, At, Bt) do { __builtin_amdgcn_s_setprio(1); _Pragma("unroll") for (int m = 0; m < 4; ++m) _Pragma("unroll") for (int n = 0; n < 2; ++n) _Pragma("unroll") for (int k = 0; k < 2; ++k) \
        acc[ai][bj][m][n] = __builtin_amdgcn_mfma_f32_16x16x32_bf16(Bt[n][k], At[m][k], acc[ai][bj][m][n], 0, 0, 0); __builtin_amdgcn_s_setprio(0); } while (0)
#define PG8_WAIT_V(n) asm volatile("s_waitcnt vmcnt(" #n ")" ::: "memory")
#define PG8_WAIT_L(n) asm volatile("s_waitcnt lgkmcnt(" #n ")" ::: "memory")
#define PG8_BAR __builtin_amdgcn_s_barrier()
#define PG8_SCHED __builtin_amdgcn_sched_barrier(0)
    Unit cur, nxt; int ui = 0;
    if (!S.next(0, cur)) return;
    f32x4 acc[2][2][4][2];
#pragma unroll
    for (int a = 0; a < 2; ++a)
#pragma unroll
        for (int b = 0; b < 2; ++b)
#pragma unroll
            for (int m = 0; m < 4; ++m)
#pragma unroll
                for (int n = 0; n < 2; ++n) acc[a][b][m][n] = (f32x4){0.f, 0.f, 0.f, 0.f};
    bf16x8 At[4][2], B0[2][2], B1[2][2];
    const char* cA = (const char*)g.A + (size_t)cur.pm * tstep; const char* cB = (const char*)g.Bt + (size_t)cur.pn * tstep;
    S.a_ready(cur);
    if constexpr (SP2) {
        PG8_STAGE(PG8_SB(0, 0), cB, voffB); PG8_STAGE(PG8_SB(0, 1), cB + hstep, voffB); PG8_STAGE(PG8_SA(0, 0), cA, voffA); PG8_STAGE(PG8_SA(0, 1), cA + hstep, voffA);
        if (wr == 1) PG8_BAR;
        PG8_WAIT_V(2); PG8_BAR;
        PG8_STAGE(PG8_SB(1, 0), cB + kstep, voffB); PG8_STAGE(PG8_SA(1, 0), cA + kstep, voffA); PG8_STAGE(PG8_SB(1, 1), cB + hstep + kstep, voffB);
        PG8_WAIT_V(6); PG8_BAR;
    } else {
        PG8_STAGE(PG8_SB(0, 0), cB, voffB); PG8_STAGE(PG8_SA(0, 0), cA, voffA); PG8_STAGE(PG8_SB(0, 1), cB + hstep, voffB); PG8_STAGE(PG8_SA(0, 1), cA + hstep, voffA);
        if (wr == 1) PG8_BAR;
        PG8_WAIT_V(4); PG8_BAR;
        PG8_STAGE(PG8_SB(1, 0), cB + kstep, voffB); PG8_STAGE(PG8_SA(1, 0), cA + kstep, voffA); PG8_STAGE(PG8_SB(1, 1), cB + hstep + kstep, voffB);
        PG8_WAIT_V(6); PG8_BAR;
    }
    for (;;) {
        const bool has_next = S.next(ui + 1, nxt);
        const char* nA = has_next ? (const char*)g.A + (size_t)nxt.pm * tstep : cA; const char* nB = has_next ? (const char*)g.Bt + (size_t)nxt.pn * tstep : cB;
        for (int t = 0; t < nt; t += 2) {
            const bool last = (t == nt - 2);
            const char* a1 = cA + (size_t)(t + 1) * kstep;
            const char* a2 = last ? nA : cA + (size_t)(t + 2) * kstep; const char* b2 = last ? nB : cB + (size_t)(t + 2) * kstep;
            const char* a3 = a2 + kstep; const char* b3 = b2 + kstep;
            if (last && has_next) S.a_ready(nxt);
            if constexpr (SP2) {
            PG8_LDB(B0, 0, 0); PG8_LDB(B1, 0, 1); PG8_SCHED; PG8_LDA(At, 0, 0); PG8_STAGE(PG8_SA(1, 1), a1 + hstep, voffA);
            PG8_WAIT_V(8); PG8_WAIT_L(0); PG8_BAR; PG8_MMA(0, 0, At, B0); PG8_MMA(0, 1, At, B1); PG8_BAR; PG8_SCHED;
            PG8_LDA(At, 0, 1); PG8_STAGE(PG8_SB(0, 0), b2, voffB); PG8_STAGE(PG8_SB(0, 1), b2 + hstep, voffB); PG8_STAGE(PG8_SA(0, 0), a2, voffA);
            PG8_WAIT_V(8); PG8_WAIT_L(0); PG8_BAR; PG8_MMA(1, 0, At, B0); PG8_MMA(1, 1, At, B1); PG8_BAR; PG8_SCHED;
            PG8_LDB(B0, 1, 0); PG8_LDB(B1, 1, 1); PG8_SCHED; PG8_LDA(At, 1, 0); PG8_STAGE(PG8_SA(0, 1), a2 + hstep, voffA);
            PG8_WAIT_V(8); PG8_WAIT_L(0); PG8_BAR; PG8_MMA(0, 0, At, B0); PG8_MMA(0, 1, At, B1); PG8_BAR; PG8_SCHED;
            PG8_LDA(At, 1, 1); PG8_STAGE(PG8_SB(1, 0), b3, voffB); PG8_STAGE(PG8_SB(1, 1), b3 + hstep, voffB); PG8_STAGE(PG8_SA(1, 0), a3, voffA);
            PG8_WAIT_V(8); PG8_WAIT_L(0); PG8_BAR; PG8_MMA(1, 0, At, B0); PG8_MMA(1, 1, At, B1); PG8_BAR; PG8_SCHED;
            } else {
            PG8_LDB(B0, 0, 0); PG8_SCHED; PG8_LDA(At, 0, 0); PG8_STAGE(PG8_SA(1, 1), a1 + hstep, voffA);
            PG8_WAIT_L(8); PG8_BAR; PG8_WAIT_L(0); PG8_MMA(0, 0, At, B0); PG8_BAR; PG8_SCHED;
            PG8_LDB(B1, 0, 1); PG8_STAGE(PG8_SB(0, 0), b2, voffB);
            PG8_BAR; PG8_WAIT_L(0); PG8_MMA(0, 1, At, B1); PG8_BAR;
            PG8_LDA(At, 0, 1); PG8_STAGE(PG8_SA(0, 0), a2, voffA);
            PG8_BAR; PG8_WAIT_L(0); PG8_MMA(1, 0, At, B0); PG8_BAR; PG8_SCHED;
            PG8_STAGE(PG8_SB(0, 1), b2 + hstep, voffB);
            PG8_WAIT_V(6); PG8_BAR; PG8_MMA(1, 1, At, B1); PG8_BAR;
            PG8_LDB(B0, 1, 0); PG8_SCHED; PG8_LDA(At, 1, 0); PG8_STAGE(PG8_SA(0, 1), a2 + hstep, voffA);
            PG8_WAIT_L(8); PG8_BAR; PG8_WAIT_L(0); PG8_MMA(0, 0, At, B0); PG8_BAR; PG8_SCHED;
            PG8_LDB(B1, 1, 1); PG8_STAGE(PG8_SB(1, 0), b3, voffB);
            PG8_BAR; PG8_WAIT_L(0); PG8_MMA(0, 1, At, B1); PG8_BAR;
            PG8_LDA(At, 1, 1); PG8_STAGE(PG8_SA(1, 0), a3, voffA);
            PG8_BAR; PG8_WAIT_L(0); PG8_MMA(1, 0, At, B0); PG8_BAR; PG8_SCHED;
            PG8_STAGE(PG8_SB(1, 1), b3 + hstep, voffB);
            PG8_WAIT_V(6); PG8_BAR; PG8_MMA(1, 1, At, B1); PG8_BAR;
            }
        }
        if constexpr (ALIGN_EPI) { if (wr == 0) PG8_BAR; }
        if constexpr (!Epi::AFTER_DRAIN) { E(acc, cur, wr, wc, fr, fq); S.done(cur); }
        if (!has_next) break;
#pragma unroll
        for (int a = 0; a < 2; ++a)
#pragma unroll
            for (int b = 0; b < 2; ++b)
#pragma unroll
                for (int m = 0; m < 4; ++m)
#pragma unroll
                    for (int n = 0; n < 2; ++n) acc[a][b][m][n] = (f32x4){0.f, 0.f, 0.f, 0.f};
        cur = nxt; cA = nA; cB = nB; ++ui;
        if constexpr (ALIGN_EPI) { if (wr == 1) PG8_BAR; }
    }
    PG8_WAIT_V(0);
    if constexpr (!ALIGN_EPI) { if (wr == 0) PG8_BAR; }
    PG8_BAR;
    if constexpr (Epi::AFTER_DRAIN) { E.fused(acc, cur, wr, wc, fr, fq, lds, wid, lane); S.done(cur); }
#undef PG8_SA
#undef PG8_SB
#undef PG8_STAGE
#undef PG8_LDA
#undef PG8_LDB
#undef PG8_MMA
#undef PG8_WAIT_V
#undef PG8_WAIT_L
#undef PG8_BAR
#undef PG8_SCHED
}
}

#define XB_TMO      128
#define XB_XCNT(j)  (256  + 64 * (j))
#define XB_XSUB(j)  (1280 + 64 * (j))
#define XB_XGEN(j)  (2304 + 64 * (j))
#define XB_TOP      3328
#define XB_TOPGEN   3392
#define XCD_BAR_WORDS 3456
#define XB_SPIN_CAP (1u << 18)

__device__ __forceinline__ unsigned xb_ld(unsigned* p)              { return __hip_atomic_load(p, __ATOMIC_RELAXED, __HIP_MEMORY_SCOPE_AGENT); }
__device__ __forceinline__ unsigned xb_add(unsigned* p, unsigned v) { return __hip_atomic_fetch_add(p, v, __ATOMIC_RELAXED, __HIP_MEMORY_SCOPE_AGENT); }
__device__ __forceinline__ unsigned xb_xcc_id() { return (unsigned)__builtin_amdgcn_s_getreg((3 << 11) | 20) & 0xFu; }
#define XB_SPIN(cond, bar) do { unsigned _sp = 0; while (cond) { __builtin_amdgcn_s_sleep(1); \
    if ((++_sp & 255u) == 0u) { if (xb_ld(&(bar)[XB_TMO])) break; if (_sp > XB_SPIN_CAP) { atomicAdd(&(bar)[XB_TMO], 1u); break; } } } } while (0)

struct XcdBarrier {
    unsigned* bar; unsigned x;
    volatile LAS unsigned* st;
};

__device__ __forceinline__ XcdBarrier xcd_barrier_post(unsigned* bar, volatile LAS unsigned* st) {
    XcdBarrier b; b.bar = bar; b.x = xb_xcc_id(); b.st = st;
    if (threadIdx.x == 0) (void)xb_add(&bar[XB_XCNT(b.x)], 1u);
    return b;
}
__device__ __forceinline__ void xcd_barrier_complete(unsigned* bar, unsigned x, unsigned& nloc, unsigned& nx) {
    const unsigned G = gridDim.x * gridDim.y * gridDim.z;
    unsigned sum, cnt, mine, sp = 0u;
    for (;;) {
        sum = 0u; cnt = 0u; mine = 0u;
#pragma unroll
        for (unsigned j = 0; j < 16; ++j) { const unsigned c = xb_ld(&bar[XB_XCNT(j)]); sum += c; cnt += (c > 0u) ? 1u : 0u; mine = (j == x) ? c : mine; }
        if (sum == G) break;
        __builtin_amdgcn_s_sleep(1);
        if ((++sp & 255u) == 0u) { if (xb_ld(&bar[XB_TMO])) break; if (sp > XB_SPIN_CAP) { atomicAdd(&bar[XB_TMO], 1u); break; } }
    }
    nloc = mine > 0u ? mine : 1u; nx = cnt > 0u ? cnt : 1u;
}

__device__ __forceinline__ void xcd_barrier(const XcdBarrier& b) {
    asm volatile("s_waitcnt vmcnt(0)" ::: "memory");
    __syncthreads();
    if (threadIdx.x == 0) {
        unsigned* bar = b.bar;
        __builtin_amdgcn_s_waitcnt(0);
        unsigned nloc = b.st[0], nx = b.st[1];
        if (nloc == 0u) { xcd_barrier_complete(bar, b.x, nloc, nx); b.st[0] = nloc; b.st[1] = nx; }
        const unsigned old = xb_add(&bar[XB_XSUB(b.x)], 1u);
        const unsigned gen = old / nloc;
        if (old + 1u == (gen + 1u) * nloc) {
            __builtin_amdgcn_fence(__ATOMIC_RELEASE, "agent");
            asm volatile("s_waitcnt vmcnt(0)" ::: "memory");
            const unsigned og = xb_add(&bar[XB_TOP], 1u);
            const unsigned tg = og / nx;
            if (og + 1u == (tg + 1u) * nx) xb_add(&bar[XB_TOPGEN], 1u);
            else XB_SPIN(xb_ld(&bar[XB_TOPGEN]) == tg, bar);
            __builtin_amdgcn_fence(__ATOMIC_ACQUIRE, "agent");
            xb_add(&bar[XB_XGEN(b.x)], 1u);
            asm volatile("s_waitcnt vmcnt(0)" ::: "memory");
        } else {
            XB_SPIN(xb_ld(&bar[XB_XGEN(b.x)]) == gen, bar);
            __builtin_amdgcn_fence(__ATOMIC_ACQUIRE, "agent");
            asm volatile("s_waitcnt vmcnt(0)" ::: "memory");
        }
    }
    __syncthreads();
}


namespace fa {
DEVI int otid() { int t = threadIdx.x; asm volatile("" : "+v"(t)); return t; }
typedef float f32x16 __attribute__((ext_vector_type(16)));
typedef short s16x4 __attribute__((ext_vector_type(4)));
constexpr int SHM_V = 16384, SHM_K = 16384;
constexpr int OFF_V = 0, OFF_K = 2 * SHM_V, OFF_WS = OFF_K + 2 * SHM_K  , OFF_MASK = OFF_WS + 2048  , OFF_BIAS = OFF_MASK + 8192  ;
constexpr float C2 = SCALE * 1.4426950408889634f;
#define FA_KSWZ(row, colB) ((row) * 256 + ((colB) ^ (((row) & 7) << 4)))
#define FA_SBAR() __builtin_amdgcn_sched_barrier(0)
DEVI int crow(int r, int hi) { return (r & 3) + 8 * (r >> 2) + 4 * hi; }
DEVI unsigned cvtpk(float lo, float hi) { unsigned r; asm volatile("v_cvt_pk_bf16_f32 %0, %1, %2" : "=v"(r) : "v"(lo), "v"(hi)); return r; }
DEVI float xlane32(float v) { return __shfl_xor(v, 32); }
DEVI void qkt(f32x16& p0, f32x16& p1, LAS const unsigned char* Ks, const bf16x8* qr, int r32, int hi) {
    p0 = (f32x16){0.f, 0.f, 0.f, 0.f, 0.f, 0.f, 0.f, 0.f, 0.f, 0.f, 0.f, 0.f, 0.f, 0.f, 0.f, 0.f}; p1 = p0;
#pragma unroll
    for (int d0 = 0; d0 < 8; ++d0) { const int cb = (d0 * 16 + hi * 8) * 2;
        const bf16x8 b0 = *(LAS const bf16x8*)(Ks + FA_KSWZ(r32, cb));
        const bf16x8 b1 = *(LAS const bf16x8*)(Ks + FA_KSWZ(32 + r32, cb));
        p0 = __builtin_amdgcn_mfma_f32_32x32x16_bf16(b0, qr[d0], p0, 0, 0, 0);
        p1 = __builtin_amdgcn_mfma_f32_32x32x16_bf16(b1, qr[d0], p1, 0, 0, 0); }
}
DEVI int v_st(int k, int c) { const int kk = (k & ~0xC) | ((k & 4) << 1) | ((k & 8) >> 1); return ((kk >> 3) * 4 + (c >> 5)) * 512 + ((kk & 7) * 32 + (c & 31)) * 2; }
DEVI int v_rd_base(int lane) { return ((lane & 3) << 3) | (((lane >> 2) & 3) << 6) | (((lane >> 4) & 1) << 5) | (((lane >> 5) & 1) << 8); }
constexpr int v_rd_off(int d0, int ks, int half) { return d0 * 512 + ks * 4096 + half * 2048; }
template <int OFF> DEVI s16x4 tr_read(int vb) { s16x4 r; asm volatile("ds_read_b64_tr_b16 %0, %1 offset:%2" : "=&v"(r) : "v"(vb), "i"(OFF) : "memory"); return r; }
template <int D0> DEVI void pv_one(f32x16& od, int vb, bf16x8 pa0, bf16x8 pa1, bf16x8 pa2, bf16x8 pa3) {
    const s16x4 l0 = tr_read<v_rd_off(D0, 0, 0)>(vb), h0 = tr_read<v_rd_off(D0, 0, 1)>(vb), l1 = tr_read<v_rd_off(D0, 1, 0)>(vb), h1 = tr_read<v_rd_off(D0, 1, 1)>(vb);
    const s16x4 l2 = tr_read<v_rd_off(D0, 2, 0)>(vb), h2 = tr_read<v_rd_off(D0, 2, 1)>(vb), l3 = tr_read<v_rd_off(D0, 3, 0)>(vb), h3 = tr_read<v_rd_off(D0, 3, 1)>(vb);
    asm volatile("s_waitcnt lgkmcnt(0)" ::: "memory"); FA_SBAR();
#define FA_PK(L, H) (bf16x8){L[0], L[1], L[2], L[3], H[0], H[1], H[2], H[3]}
    od = __builtin_amdgcn_mfma_f32_32x32x16_bf16(pa0, FA_PK(l0, h0), od, 0, 0, 0);
    od = __builtin_amdgcn_mfma_f32_32x32x16_bf16(pa1, FA_PK(l1, h1), od, 0, 0, 0);
    od = __builtin_amdgcn_mfma_f32_32x32x16_bf16(pa2, FA_PK(l2, h2), od, 0, 0, 0);
    od = __builtin_amdgcn_mfma_f32_32x32x16_bf16(pa3, FA_PK(l3, h3), od, 0, 0, 0);
#undef FA_PK
}
DEVI void pv_d0(f32x16* o, int vb, bf16x8 pa0, bf16x8 pa1, bf16x8 pa2, bf16x8 pa3) {
    pv_one<0>(o[0], vb, pa0, pa1, pa2, pa3); pv_one<1>(o[1], vb, pa0, pa1, pa2, pa3); pv_one<2>(o[2], vb, pa0, pa1, pa2, pa3); pv_one<3>(o[3], vb, pa0, pa1, pa2, pa3);
}
DEVI void pack_p(const f32x16& p0, const f32x16& p1, bf16x8& pa0, bf16x8& pa1, bf16x8& pa2, bf16x8& pa3) {
#define FA_PK4(P, BASE, OUT) do { unsigned a0 = cvtpk(P[BASE + 0], P[BASE + 1]), a1 = cvtpk(P[BASE + 2], P[BASE + 3]);   \
    unsigned b0 = cvtpk(P[BASE + 4], P[BASE + 5]), b1 = cvtpk(P[BASE + 6], P[BASE + 7]);                              \
    auto r0 = __builtin_amdgcn_permlane32_swap(a0, b0, false, false); auto r1 = __builtin_amdgcn_permlane32_swap(a1, b1, false, false); \
    u32x4 w = {r0[0], r1[0], r0[1], r1[1]}; OUT = *reinterpret_cast<bf16x8*>(&w); } while (0)
    FA_PK4(p0, 0, pa0); FA_PK4(p0, 8, pa1); FA_PK4(p1, 0, pa2); FA_PK4(p1, 8, pa3);
#undef FA_PK4
}

DEVI void stick_half(f32x16& x, float& carry, bool diag, int kv0, int tq, int hi) {
    f32x16 lk;
#pragma unroll
    for (int r = 0; r < 16; ++r) {
        const float z = x[r] * C2;
        const float sp = fmaxf(z, 0.f) + __builtin_amdgcn_logf(1.f + __builtin_amdgcn_exp2f(-fabsf(z)));
        float l = -sp, lb = z - sp;
        if (diag) { if (kv0 + (r & 3) + 8 * (r >> 2) >= tq) { l = 0.f; lb = -INFINITY; } }
        lk[r] = l; x[r] = lb;
    }
    float T[4], PT[4], S[4], A[4];
#pragma unroll
    for (int g = 0; g < 4; ++g) { T[g] = (lk[4 * g] + lk[4 * g + 1]) + (lk[4 * g + 2] + lk[4 * g + 3]); PT[g] = xlane32(T[g]); S[g] = T[g] + PT[g]; }
    A[3] = 0.f; A[2] = S[3]; A[1] = A[2] + S[2]; A[0] = A[1] + S[1];
#pragma unroll
    for (int g = 0; g < 4; ++g) {
        const float a3 = carry + A[g] + (hi == 0 ? PT[g] : 0.f), a2 = a3 + lk[4 * g + 3], a1 = a2 + lk[4 * g + 2], a0 = a1 + lk[4 * g + 1];
        x[4 * g + 3] = __builtin_amdgcn_exp2f(x[4 * g + 3] + a3); x[4 * g + 2] = __builtin_amdgcn_exp2f(x[4 * g + 2] + a2);
        x[4 * g + 1] = __builtin_amdgcn_exp2f(x[4 * g + 1] + a1); x[4 * g] = __builtin_amdgcn_exp2f(x[4 * g] + a0);
    }
    carry += A[0] + S[0];
}

enum { M_CROSS = 0, M_BAND = 1, M_DSA = 2, M_STICK = 3 };
template <int MODE>
DEVI void attn_unit(LAS unsigned char* lds, const bf16_t* Qw, int ldq, const bf16_t* Kb, const bf16_t* Vb, int ldk, bf16_t* Ow, int ldo,
                    int j_first, int ntiles, int jstep, int wj_lo, int wj_hi, int t0) {
    const int tid = otid(), wid = tid >> 6, lane = tid & 63, r32 = lane & 31, hi = lane >> 5;
    LAS unsigned char* V_lds = lds + OFF_V; LAS unsigned char* K_lds = lds + OFF_K;
    LAS float* wsx = (LAS float*)(lds + OFF_WS) + wid * 64; LAS float* li_l = wsx; LAS float* al_l = wsx + 32;
    LAS const float* bias2 = (LAS const float*)(lds + OFF_BIAS); LAS const u64* maskl = (LAS const u64*)(lds + OFF_MASK);
    float m_reg = -1e30f, l_reg = 0.f, carry = 0.f;
    f32x16 o[4];
#pragma unroll
    for (int d = 0; d < 4; ++d) o[d] = (f32x16){0.f, 0.f, 0.f, 0.f, 0.f, 0.f, 0.f, 0.f, 0.f, 0.f, 0.f, 0.f, 0.f, 0.f, 0.f, 0.f};
    bf16x8 qr[8];
    { const bf16_t* qp = Qw + (size_t)r32 * ldq + hi * 8;
#pragma unroll
      for (int d0 = 0; d0 < 8; ++d0) qr[d0] = *(const bf16x8*)(qp + d0 * 16); }
    const int sr = tid >> 4, sc = (tid & 15) * 8, vst0 = v_st(sr, sc), vst1 = v_st(32 + sr, sc);
    const int kst0 = FA_KSWZ(sr, sc * 2), kst1 = FA_KSWZ(32 + sr, sc * 2);
    const int vb0 = (int)(uintptr_t)V_lds + v_rd_base(lane);
    bf16x8 vs0, vs1, ks0, ks1;
#define FA_SLOAD(jj) do { const size_t k0_ = (size_t)(jj) * 64; vs0 = *(const bf16x8*)(Vb + (k0_ + sr) * ldk + sc); vs1 = *(const bf16x8*)(Vb + (k0_ + 32 + sr) * ldk + sc); \
        ks0 = *(const bf16x8*)(Kb + (k0_ + sr) * ldk + sc); ks1 = *(const bf16x8*)(Kb + (k0_ + 32 + sr) * ldk + sc); } while (0)
#define FA_SWRITE(b) do { *(LAS bf16x8*)(V_lds + (b) * SHM_V + vst0) = vs0; *(LAS bf16x8*)(V_lds + (b) * SHM_V + vst1) = vs1; \
        *(LAS bf16x8*)(K_lds + (b) * SHM_K + kst0) = ks0; *(LAS bf16x8*)(K_lds + (b) * SHM_K + kst1) = ks1; } while (0)
    int j = j_first;
    FA_SLOAD(j);
    for (int i = 0; i < ntiles; ++i, j += jstep) {
        const int buf = i & 1;
        FA_SWRITE(buf);
        asm volatile("" ::: "memory");
        if (i + 1 < ntiles) FA_SLOAD(j + jstep);
        asm volatile("s_waitcnt lgkmcnt(0)" ::: "memory"); __builtin_amdgcn_s_barrier(); asm volatile("" ::: "memory");
        if (j >= wj_lo && j <= wj_hi) {
            f32x16 p0, p1;
            qkt(p0, p1, K_lds + buf * SHM_K, qr, r32, hi);
            bf16x8 pa0, pa1, pa2, pa3;
            if constexpr (MODE == M_STICK) {
                const int tq = t0 + r32; const bool diag = (64 * j + 63 >= t0);
                stick_half(p1, carry, diag, 64 * j + 32 + 4 * hi, tq, hi);
                stick_half(p0, carry, diag, 64 * j + 4 * hi, tq, hi);
                pack_p(p0, p1, pa0, pa1, pa2, pa3);
            } else {
                if constexpr (MODE == M_BAND) {
                    const int cw = t0 >> 6;
                    if (j <= cw - 3) { const float bc = bias2[191];
#pragma unroll
                        for (int r = 0; r < 16; ++r) { p0[r] = fmaf(p0[r], C2, bc); p1[r] = fmaf(p1[r], C2, bc); }
                    } else { const int d0 = (t0 + r32) - (64 * j + 4 * hi) + 63;
#pragma unroll
                        for (int r = 0; r < 16; ++r) { const int da = d0 - ((r & 3) + 8 * (r >> 2)); const int ia = da > 191 ? 191 : da; const int db = da - 32; const int ib = db > 191 ? 191 : db;
                            p0[r] = fmaf(p0[r], C2, bias2[ia]); p1[r] = fmaf(p1[r], C2, bias2[ib]); } }
                } else if constexpr (MODE == M_DSA) {
                    const u64 mw = maskl[r32 * 32 + j]; const unsigned mlo = (unsigned)(mw >> (4 * hi)), mhi = (unsigned)(mw >> (32 + 4 * hi));
#pragma unroll
                    for (int r = 0; r < 16; ++r) { const int kbit = (r & 3) + 8 * (r >> 2);
                        p0[r] = ((mlo >> kbit) & 1u) ? p0[r] * C2 : -INFINITY; p1[r] = ((mhi >> kbit) & 1u) ? p1[r] * C2 : -INFINITY; }
                } else {
#pragma unroll
                    for (int r = 0; r < 16; ++r) { p0[r] *= C2; p1[r] *= C2; }
                }
                float pmax = p0[0];
#pragma unroll
                for (int r = 1; r < 16; ++r) pmax = fmaxf(pmax, p0[r]);
#pragma unroll
                for (int r = 0; r < 16; ++r) pmax = fmaxf(pmax, p1[r]);
                pmax = fmaxf(pmax, xlane32(pmax));
                const float mn = fmaxf(m_reg, pmax), alpha = __builtin_amdgcn_exp2f(m_reg - mn); m_reg = mn;
                float ps = 0.f;
#pragma unroll
                for (int r = 0; r < 16; ++r) { p0[r] = __builtin_amdgcn_exp2f(p0[r] - mn); p1[r] = __builtin_amdgcn_exp2f(p1[r] - mn); ps += p0[r] + p1[r]; }
                ps += xlane32(ps);
                l_reg = l_reg * alpha + ps;
                if (__any(alpha < 1.f)) { if (hi == 0) al_l[r32] = alpha; asm volatile("s_waitcnt lgkmcnt(0)" ::: "memory");
#pragma unroll
                    for (int r = 0; r < 16; ++r) { const float af = al_l[crow(r, hi)];
#pragma unroll
                        for (int d = 0; d < 4; ++d) o[d][r] *= af; } }
                pack_p(p0, p1, pa0, pa1, pa2, pa3);
            }
            pv_d0(o, vb0 + buf * SHM_V, pa0, pa1, pa2, pa3);
        }
    }
    float rli[16];
    if constexpr (MODE != M_STICK) {
        if (hi == 0) li_l[r32] = l_reg; asm volatile("s_waitcnt lgkmcnt(0)" ::: "memory");
#pragma unroll
        for (int r = 0; r < 16; ++r) rli[r] = 1.f / li_l[crow(r, hi)];
    } else {
#pragma unroll
        for (int r = 0; r < 16; ++r) rli[r] = 1.f;
    }
#pragma unroll
    for (int r = 0; r < 16; ++r) { bf16_t* op = Ow + (size_t)crow(r, hi) * ldo + r32;
#pragma unroll
        for (int d0 = 0; d0 < 4; ++d0) op[d0 * 32] = (bf16_t)f2bf(o[d0][r] * rli[r]); }
    asm volatile("s_waitcnt lgkmcnt(0)" ::: "memory"); __builtin_amdgcn_s_barrier(); asm volatile("" ::: "memory");
#undef FA_SLOAD
#undef FA_SWRITE
}

DEVI void cross_phase(LAS unsigned char* lds, const bf16_t* XQ, const bf16_t* KVX, bf16_t* XO, int layer) {
    const int wid = otid() >> 6;
    for (int u = blockIdx.x; u < NB * 4 * 8; u += gridDim.x) {
        const int qb = u & 7, h = (u >> 3) & 3, b = u >> 5; const int m0 = b * SEQ + qb * 256 + wid * 32;
        attn_unit<M_CROSS>(lds, XQ + (size_t)m0 * 512 + h * HD, 512, KVX + (size_t)(b * MEML) * 4096 + layer * 1024 + h * HD, KVX + (size_t)(b * MEML) * 4096 + layer * 1024 + 512 + h * HD, 4096,
                           XO + (size_t)m0 * 512 + h * HD, 512, 0, 4, 1, 0, 1 << 30, 0);
    }
}
DEVI void band_phase(LAS unsigned char* lds, const bf16_t* EV, bf16_t* O, const float* relb  ) {
    const int wid = otid() >> 6;
    for (int u = blockIdx.x; u < NB * 8 * 8; u += gridDim.x) {
        const int qb = u & 7, h = (u >> 3) & 7, b = u >> 6; const int tw = qb * 256 + wid * 32, m0 = b * SEQ + tw, cw = tw >> 6;
        { const int tb = otid(); if (tb < RELSZ) ((LAS float*)(lds + OFF_BIAS))[tb] = relb[h * RELSZ + tb] * 1.4426950408889634f; }
        const int jlo = (4 * qb - 8) < 0 ? 0 : 4 * qb - 8, jhi = 4 * qb + 3;
        attn_unit<M_BAND>(lds, EV + (size_t)m0 * EVP + EV_QB + h * HD, EVP, EV + (size_t)(b * SEQ) * EVP + EV_KB + h * HD, EV + (size_t)(b * SEQ) * EVP + EV_VB + h * HD, EVP,
                          O + (size_t)m0 * DM + 1024 + h * HD, DM, jlo, jhi - jlo + 1, 1, cw - 8, cw, tw);
    }
}
DEVI void stick_phase(LAS unsigned char* lds, const bf16_t* QKV, bf16_t* O) {
    const int wid = otid() >> 6;
    for (int u = blockIdx.x; u < NB * 16 * 4; u += gridDim.x) {
        const int pq = u & 3, h = (u >> 2) & 15, b = u >> 6;
#pragma unroll 1
        for (int s = 0; s < 2; ++s) { const int qb = s == 0 ? 7 - pq : pq; const int tw = qb * 256 + wid * 32, m0 = b * SEQ + tw, cw = tw >> 6;
            attn_unit<M_STICK>(lds, QKV + (size_t)m0 * ODD_COLS + h * HD, ODD_COLS, QKV + (size_t)(b * SEQ) * ODD_COLS + 2048 + h * HD, QKV + (size_t)(b * SEQ) * ODD_COLS + 4096 + h * HD, ODD_COLS,
                               O + (size_t)m0 * DM + h * HD, DM, 4 * qb + 3, 4 * qb + 4, -1, 0, cw, tw); }
    }
}
DEVI void indexer_phase(LAS unsigned char* lds, const bf16_t* EV, float* SC) {
    const int tid = otid(), wid = tid >> 6, lane = tid & 63, r32 = lane & 31, hi = lane >> 5;
    LAS float* wl = (LAS float*)(lds + 66560);
    for (int u = blockIdx.x; u < NB * 64; u += gridDim.x) {
        const int g = u & 63, b = u >> 6, m0 = b * SEQ + 32 * g, nt = (g >> 1) + 1;
#pragma unroll
        for (int k = 0; k < 8; ++k) { const int idx = tid + 512 * k, row = idx >> 7, ch = idx & 127;
            *(LAS bf16x8*)(lds + row * 2080 + ch * 16) = *(const bf16x8*)(EV + (size_t)(m0 + row) * EVP + EV_QI + ch * 8); }
        wl[tid] = bf2f(EV[(size_t)(m0 + (tid & 31)) * EVP + EV_WI + (tid >> 5)]);
        asm volatile("s_waitcnt lgkmcnt(0)" ::: "memory"); __builtin_amdgcn_s_barrier(); asm volatile("" ::: "memory");
        for (int j = wid; j < nt; j += 8) {
            bf16x8 kf[2][4];
#pragma unroll
            for (int hf = 0; hf < 2; ++hf)
#pragma unroll
                for (int ks = 0; ks < 4; ++ks) kf[hf][ks] = *(const bf16x8*)(EV + (size_t)(b * SEQ + 64 * j + 32 * hf + r32) * EVP + EV_KI + 16 * ks + 8 * hi);
            f32x16 acc0 = (f32x16){0.f, 0.f, 0.f, 0.f, 0.f, 0.f, 0.f, 0.f, 0.f, 0.f, 0.f, 0.f, 0.f, 0.f, 0.f, 0.f}, acc1 = acc0;
#pragma unroll 1
            for (int h = 0; h < 16; ++h) {
                bf16x8 qf[4];
#pragma unroll
                for (int ks = 0; ks < 4; ++ks) qf[ks] = *(LAS const bf16x8*)(lds + r32 * 2080 + (h * 64 + 16 * ks + 8 * hi) * 2);
                f32x4 wv[4];
#pragma unroll
                for (int a4 = 0; a4 < 4; ++a4) wv[a4] = *(LAS const f32x4*)(wl + h * 32 + 8 * a4 + 4 * hi);
                f32x16 s0 = (f32x16){0.f, 0.f, 0.f, 0.f, 0.f, 0.f, 0.f, 0.f, 0.f, 0.f, 0.f, 0.f, 0.f, 0.f, 0.f, 0.f}, s1 = s0;
#pragma unroll
                for (int ks = 0; ks < 4; ++ks) { s0 = __builtin_amdgcn_mfma_f32_32x32x16_bf16(qf[ks], kf[0][ks], s0, 0, 0, 0); s1 = __builtin_amdgcn_mfma_f32_32x32x16_bf16(qf[ks], kf[1][ks], s1, 0, 0, 0); }
#pragma unroll
                for (int r = 0; r < 16; ++r) { const float w = wv[r >> 2][r & 3]; acc0[r] = fmaf(w, fmaxf(s0[r], 0.f), acc0[r]); acc1[r] = fmaf(w, fmaxf(s1[r], 0.f), acc1[r]); }
            }
#pragma unroll
            for (int r = 0; r < 16; ++r) { float* sp = SC + (size_t)(m0 + crow(r, hi)) * SEQ + 64 * j + r32; sp[0] = acc0[r]; sp[32] = acc1[r]; }
        }
        asm volatile("s_waitcnt lgkmcnt(0)" ::: "memory"); __builtin_amdgcn_s_barrier(); asm volatile("" ::: "memory");
    }
}
DEVI void dsa_phase(LAS unsigned char* lds, const bf16_t* EV, const float* SC, bf16_t* O) {
    const int tid = otid(), wid = tid >> 6, lane = tid & 63;
    LAS u64* maskl = (LAS u64*)(lds + OFF_MASK);
    for (int u = blockIdx.x; u < NB * 64; u += gridDim.x) {
        const int g = 63 - (u & 63), b = u >> 6, t0 = 32 * g, m0 = b * SEQ + t0, c = g >> 1;
#pragma unroll 1
        for (int rr = 0; rr < 4; ++rr) { const int row = 4 * wid + rr; select_row(SC + (size_t)(m0 + row) * SEQ, c, maskl + row * 32, lane); }
        asm volatile("s_waitcnt lgkmcnt(0)" ::: "memory"); __builtin_amdgcn_s_barrier(); asm volatile("" ::: "memory");
        attn_unit<M_DSA>(lds, EV + (size_t)m0 * EVP + EV_QA + wid * HD, EVP, EV + (size_t)(b * SEQ) * EVP + EV_KA, EV + (size_t)(b * SEQ) * EVP + EV_VA, EVP,
                         O + (size_t)m0 * DM + wid * HD, DM, 0, c + 1, 1, 0, 1 << 30, t0);
    }
}
}

constexpr int RING_BYTES = 131072, LDSCTL_OFF = RING_BYTES, MISC_OFF = LDSCTL_OFF + 320, LDS_BYTES = 147456;
constexpr int CW_BAR = 4096;
constexpr int N_STEPS = 2 + 16 * 8;
struct MegaArgs { const float* in[14]; float* out; unsigned char* ws; int st_lo, st_hi; };

DEVI void prologue_phase(const MegaArgs& a, LAS unsigned char* lds, int wave, int lane, int gw, int ngw) {
    unsigned char* ws = a.ws;
    LAS float* scr = (LAS float*)(lds + wave * 8448);
#pragma unroll 1
    for (int lj = 0; lj < 8; ++lj) {
        convert_matrix(a.in[4] + (size_t)lj * DM * 2 * FFN, 2 * FFN, 2 * FFN, DM, (bf16_t*)(ws + WS_WF_FFN_IN + lj * SZ_FFN_IN), 2 * FFN / 32, 1, gw, ngw, scr, lane);
        convert_matrix(a.in[5] + (size_t)lj * FFN * DM, DM, DM, FFN, (bf16_t*)(ws + WS_W_FFN_OUT + lj * SZ_FFN_OUT), DM / 32, 0, gw, ngw, scr, lane);
    }
#pragma unroll 1
    for (int i = 0; i < 2; ++i) {
        convert_matrix(a.in[9] + (size_t)i * DM * EVEN_COLS, EVEN_COLS, EVEN_COLS, DM, (bf16_t*)(ws + WS_WF_EVEN_IN + i * SZ_EVEN_IN), EVP / 32, 2, gw, ngw, scr, lane);
        convert_matrix(a.in[12] + (size_t)i * DM * ODD_COLS, ODD_COLS, ODD_COLS, DM, (bf16_t*)(ws + WS_W_ODD_IN + i * SZ_ODD_IN), ODD_COLS / 32, 0, gw, ngw, scr, lane);
        convert_matrix(a.in[10] + (size_t)i * DM * DM, DM, DM, DM, (bf16_t*)(ws + WS_W_MIX_OUT + (2 * i) * SZ_MIX_OUT), DM / 32, 0, gw, ngw, scr, lane);
        convert_matrix(a.in[13] + (size_t)i * DM * DM, DM, DM, DM, (bf16_t*)(ws + WS_W_MIX_OUT + (2 * i + 1) * SZ_MIX_OUT), DM / 32, 0, gw, ngw, scr, lane);
    }
#pragma unroll 1
    for (int l = 0; l < DEPTH; ++l) {
        convert_matrix(a.in[6] + (size_t)l * DM * 512, 512, 512, DM, (bf16_t*)(ws + WS_W_XQ + l * SZ_XQ), 512 / 32, 0, gw, ngw, scr, lane);
        convert_matrix(a.in[7] + (size_t)l * DM * 1024, 1024, 1024, DM, (bf16_t*)(ws + WS_W_XKV + l * SZ_XKV), 1024 / 32, 0, gw, ngw, scr, lane);
        convert_matrix(a.in[8] + (size_t)l * 512 * DM, DM, DM, 512, (bf16_t*)(ws + WS_W_XO + l * SZ_XO), DM / 32, 0, gw, ngw, scr, lane);
    }
    const int gt = gw * 64 + lane, ngt = ngw * 64;
    f32x2* t128 = (f32x2*)(ws + WS_ROPE128); f32x2* t64 = (f32x2*)(ws + WS_ROPE64);
    for (int i = gt; i < SEQ * 96; i += ngt) {
        const int pos = i / 96, f = i % 96; const bool big = f < 64; const int ff = big ? f : f - 64; const double half = big ? 64.0 : 32.0;
        const double inv = exp2(-(double)ff / half * 13.287712379549449);
        const double rev = (double)pos * inv * 0.15915494309189535; const double fr = rev - rint(rev);
        const float c = __builtin_amdgcn_cosf((float)fr), s = __builtin_amdgcn_sinf((float)fr);
        if (big) t128[pos * 64 + ff] = (f32x2){c, s}; else t64[pos * 32 + ff] = (f32x2){c, s};
    }
    { const f32x4* x4 = (const f32x4*)a.in[0]; f32x4* X4 = (f32x4*)(ws + WS_X); u32x2* XB2 = (u32x2*)(ws + WS_XB);
      for (int i = gt; i < MT * DM / 4; i += ngt) { const f32x4 v = x4[i]; X4[i] = v; u32x2 o; o.x = pk2(v.x, v.y); o.y = pk2(v.z, v.w); XB2[i] = o; }
      const f32x4* m4 = (const f32x4*)a.in[1]; u32x2* MB2 = (u32x2*)(ws + WS_MEMB);
      for (int i = gt; i < NB * MEML * DM / 4; i += ngt) { const f32x4 v = m4[i]; u32x2 o; o.x = pk2(v.x, v.y); o.y = pk2(v.z, v.w); MB2[i] = o; } }
}

template <class Epi> DEVI void run_gemm(LAS unsigned char* lds, const bf16_t* A, const bf16_t* Bt, int M, int N, int K, const Epi& E) {
    pg8::Gemm g{A, Bt, M, N, K}; pg8::StaticOrder S; S.init(M, N, (int)gridDim.x, (int)blockIdx.x);
    pg8::gemm_phase<Epi, pg8::StaticOrder, true, true>(lds, g, S, E);
}

__global__ void __launch_bounds__(512, 2) k_mega(MegaArgs a) {
    extern __shared__ __attribute__((aligned(16))) unsigned char dyn_lds[];
    LAS unsigned char* lds = (LAS unsigned char*)dyn_lds;
    volatile LAS unsigned* MISC = (volatile LAS unsigned*)(lds + MISC_OFF);
    const int tid = threadIdx.x, lane_k = tid & 63, wave_k = __builtin_amdgcn_readfirstlane(tid >> 6);
    const int ngw = gridDim.x * 8;
    unsigned char* ws = a.ws;
    for (int u = tid; u < (LDS_BYTES - LDSCTL_OFF) / 4; u += 512) ((LAS unsigned*)(lds + LDSCTL_OFF))[u] = 0u;
    __syncthreads();
    XcdBarrier bar = xcd_barrier_post((unsigned*)(ws + WS_CTL) + CW_BAR, MISC + 8);
    const int lo = a.st_lo, hi = a.st_hi; bool prev = false;
#ifndef SITES
#define SITES 0xFFFF
#endif
#define STEP_BEGIN(idx) if (lo <= (idx) && (idx) < hi) { if (prev) xcd_barrier(bar); prev = true; int lane = lane_k, wave = wave_k; asm volatile("" : "+v"(lane), "+s"(wave)); const int gw = blockIdx.x * 8 + wave; (void)gw; (void)lane;
#define STEP_END }
    float* X = (float*)(ws + WS_X); bf16_t* XB = (bf16_t*)(ws + WS_XB); float* Y = (float*)(ws + WS_Y); bf16_t* H = (bf16_t*)(ws + WS_H);
    bf16_t* QKV = (bf16_t*)(ws + WS_QKV); bf16_t* O = (bf16_t*)(ws + WS_O); bf16_t* XQ = (bf16_t*)(ws + WS_XQ); bf16_t* XO = (bf16_t*)(ws + WS_XO);
    bf16_t* KVX = (bf16_t*)(ws + WS_KVX); bf16_t* MEMB = (bf16_t*)(ws + WS_MEMB); float* SC = (float*)(ws + WS_SCORES); u64* MASK = (u64*)(ws + WS_MASK);
    const f32x2* T128 = (const f32x2*)(ws + WS_ROPE128); const f32x2* T64 = (const f32x2*)(ws + WS_ROPE64);

    STEP_BEGIN(0) prologue_phase(a, lds, wave, lane, gw, ngw); STEP_END
    STEP_BEGIN(1) { pg8::EpiBf16 E{KVX, 4096}; run_gemm(lds, MEMB, (const bf16_t*)(ws + WS_W_XKV), NB * MEML, 4096, DM, E); } STEP_END
#pragma unroll 1
    for (int sb = 0; sb < 16; ++sb) {
        const int l = sb >> 2, kind = sb & 3, base = 2 + sb * 8;
        const bf16_t* oA; const bf16_t* oB; int oK; float ocs;
        if (kind == 0 || kind == 3) {
            const int lj = l * 2 + (kind == 3 ? 1 : 0);
            STEP_BEGIN(base + 0) { pg8::EpiSwiglu E{H, FFN}; run_gemm(lds, XB, (const bf16_t*)(ws + WS_WF_FFN_IN + lj * SZ_FFN_IN), MT, 2 * FFN, DM, E); } STEP_END
            oA = H; oB = (const bf16_t*)(ws + WS_W_FFN_OUT + lj * SZ_FFN_OUT); oK = FFN; ocs = 0.5f;
        } else if (kind == 1) {
            const int i = l >> 1;
            if ((l & 1) == 0) {
                STEP_BEGIN(base + 0) { pg8::EpiRope E{QKV, EVP, T128, T64, SEQ}; run_gemm(lds, XB, (const bf16_t*)(ws + WS_WF_EVEN_IN + i * SZ_EVEN_IN), MT, EVP, DM, E); } STEP_END
                STEP_BEGIN(base + 1) { fa::indexer_phase(lds, QKV, SC); fa::band_phase(lds, QKV, O, a.in[11] + (size_t)i * 8 * RELSZ); } STEP_END
                STEP_BEGIN(base + 3) { fa::dsa_phase(lds, QKV, SC, O); } STEP_END
            } else {
                STEP_BEGIN(base + 0) { pg8::EpiBf16 E{QKV, ODD_COLS}; run_gemm(lds, XB, (const bf16_t*)(ws + WS_W_ODD_IN + i * SZ_ODD_IN), MT, ODD_COLS, DM, E); } STEP_END
                STEP_BEGIN(base + 1) { fa::stick_phase(lds, QKV, O); } STEP_END
            }
            oA = O; oB = (const bf16_t*)(ws + WS_W_MIX_OUT + l * SZ_MIX_OUT); oK = DM; ocs = 1.0f;
        } else {
            STEP_BEGIN(base + 0) { pg8::EpiBf16 E{XQ, 512}; run_gemm(lds, XB, (const bf16_t*)(ws + WS_W_XQ + l * SZ_XQ), MT, 512, DM, E); } STEP_END
            STEP_BEGIN(base + 1) { fa::cross_phase(lds, XQ, KVX, XO, l); } STEP_END
            oA = XO; oB = (const bf16_t*)(ws + WS_W_XO + l * SZ_XO); oK = 512; ocs = 1.0f;
        }
        STEP_BEGIN(base + 5) { pg8::EpiResid E{X, Y, DM, ALPHA, ocs}; run_gemm(lds, oA, oB, MT, DM, oK, E); } STEP_END
        STEP_BEGIN(base + 6) {
            const float* g = a.in[2] + (size_t)(l * 4 + kind) * DM; const float* bt = a.in[3] + (size_t)(l * 4 + kind) * DM;
            float* outp = (sb == 15) ? a.out : nullptr;
            for (int m = gw; m < MT; m += ngw) ln_row(Y + (size_t)m * DM, g, bt, X + (size_t)m * DM, XB + (size_t)m * DM, outp ? outp + (size_t)m * DM : nullptr, lane);
        } STEP_END
    }
#undef STEP_BEGIN
#undef STEP_END
}

#ifndef FAST_MASK
#define FAST_MASK 0x1FFF
#endif
enum { F_PROLOGUE = 1, F_KVX = 2, F_FFN_IN = 4, F_EV_IN = 8, F_IDXBAND = 16, F_SELECT = 32, F_DSA = 64, F_OD_IN = 128, F_STICK = 256, F_XQ = 512, F_XATT = 1024, F_OUT = 2048, F_LN = 4096, F_ALL = 0x1FFF };
struct StepInfo { int flag; int sb, l, kind, sub; bool valid; };
static StepInfo step_info(int st) {
    StepInfo s{}; s.valid = true; s.sb = -1;
    if (st == 0) { s.flag = F_PROLOGUE; return s; }
    if (st == 1) { s.flag = F_KVX; return s; }
    const int sb = (st - 2) / 8, sub = (st - 2) % 8, l = sb >> 2, kind = sb & 3; s.sb = sb; s.l = l; s.kind = kind; s.sub = sub;
    if (sub == 5) { s.flag = F_OUT; return s; }
    if (sub == 6) { s.flag = F_LN; return s; }
    if (kind == 0 || kind == 3) { if (sub == 0) s.flag = F_FFN_IN; else s.valid = false; return s; }
    if (kind == 1) {
        if ((l & 1) == 0) { if (sub == 0) s.flag = F_EV_IN; else if (sub == 1) s.flag = F_IDXBAND; else if (sub == 2) { s.flag = F_DSA; s.valid = !(FAST_MASK & F_DSA); s.sub = 2; } else if (sub == 3) s.flag = F_DSA; else s.valid = false; }
        else { if (sub == 0) s.flag = F_OD_IN; else if (sub == 1) s.flag = F_STICK; else s.valid = false; }
        return s; }
    if (sub == 0) s.flag = F_XQ; else if (sub == 1) s.flag = F_XATT; else s.valid = false;
    return s;
}
static void launch_convert(hipStream_t st, const float* W, int ldw, int nsrc, int K, bf16_t* WT, int ngroups, int mode) {
    hipLaunchKernelGGL(k_convert, dim3(1024), dim3(512), 8 * 8448, st, W, ldw, nsrc, K, WT, ngroups, mode);
}
static void launch_gemm(hipStream_t st, const bf16_t* A, int lda, const bf16_t* Bt, int ldb, float* C, int ldc, int M, int N, int K) {
    hipLaunchKernelGGL(k_gemm_naive, dim3(1024), dim3(512), 0, st, A, lda, Bt, ldb, C, ldc, M, N, K);
}
static void launch_mega(hipStream_t stream, const MegaArgs& base, int lo, int hi, int grid, void* d_ws) {
    (void)hipMemsetAsync((char*)d_ws + WS_CTL, 0, 1 * MiB, stream);
    MegaArgs a = base; a.st_lo = lo; a.st_hi = hi;
    hipLaunchKernelGGL(k_mega, dim3(grid), dim3(512), LDS_BYTES, stream, a);
}
extern "C" void kernel_launch(void* const* d_in, const int* in_sizes, int n_in, void* d_out, int out_size, void* d_ws, size_t ws_size, hipStream_t stream) {
    if (n_in != 14 || in_sizes[0] != MT * DM || out_size != MT * DM || ws_size < WS_END) {
        fprintf(stderr, "kernel_launch: unexpected shapes: n_in %d in0 %d out %d ws %zu (need %zu)\n", n_in, n_in > 0 ? in_sizes[0] : -1, out_size, ws_size, (size_t)WS_END);
        return; }
    static int grid = 0;
    if (!grid) {
        (void)hipFuncSetAttribute((const void*)k_convert, hipFuncAttributeMaxDynamicSharedMemorySize, 8 * 8448);
        (void)hipFuncSetAttribute((const void*)k_indexer_naive, hipFuncAttributeMaxDynamicSharedMemorySize, 8 * 8192);
        (void)hipFuncSetAttribute((const void*)k_attn_naive<0>, hipFuncAttributeMaxDynamicSharedMemorySize, 8 * 8704);
        (void)hipFuncSetAttribute((const void*)k_attn_naive<1>, hipFuncAttributeMaxDynamicSharedMemorySize, 8 * 8704);
        (void)hipFuncSetAttribute((const void*)k_attn_naive<2>, hipFuncAttributeMaxDynamicSharedMemorySize, 8 * 8704);
        (void)hipFuncSetAttribute((const void*)k_attn_naive<3>, hipFuncAttributeMaxDynamicSharedMemorySize, 8 * 8704);
        if (hipFuncSetAttribute((const void*)k_mega, hipFuncAttributeMaxDynamicSharedMemorySize, LDS_BYTES) != hipSuccess) fprintf(stderr, "kernel_launch: hipFuncSetAttribute(k_mega) failed\n");
        int dev = 0, cus = 0, per_cu = 0;
        (void)hipGetDevice(&dev); (void)hipDeviceGetAttribute(&cus, hipDeviceAttributeMultiprocessorCount, dev);
        if (hipOccupancyMaxActiveBlocksPerMultiprocessor(&per_cu, (const void*)k_mega, 512, LDS_BYTES) != hipSuccess || per_cu < 1)
            fprintf(stderr, "kernel_launch: occupancy query reports %d blocks per CU for k_mega\n", per_cu);
        (void)hipGetLastError();
        grid = cus > 0 ? cus : 256;
    }
    unsigned char* ws = (unsigned char*)d_ws;
    MegaArgs base{};
    for (int i = 0; i < 14; ++i) base.in[i] = (const float*)d_in[i];
    base.out = (float*)d_out; base.ws = ws; base.st_lo = 0; base.st_hi = 0;
    if ((FAST_MASK & F_ALL) == F_ALL) { launch_mega(stream, base, 0, N_STEPS, grid, d_ws); return; }

    const float* x = (const float*)d_in[0]; const float* mem = (const float*)d_in[1]; const float* ln_g = (const float*)d_in[2]; const float* ln_b = (const float*)d_in[3];
    const float* ffn_in = (const float*)d_in[4]; const float* ffn_out = (const float*)d_in[5]; const float* xq = (const float*)d_in[6]; const float* xkv = (const float*)d_in[7];
    const float* xo = (const float*)d_in[8]; const float* even_in = (const float*)d_in[9]; const float* even_out = (const float*)d_in[10]; const float* relb = (const float*)d_in[11];
    const float* odd_in = (const float*)d_in[12]; const float* odd_out = (const float*)d_in[13];
    float* X = (float*)(ws + WS_X); bf16_t* XB = (bf16_t*)(ws + WS_XB); float* Y = (float*)(ws + WS_Y); bf16_t* H = (bf16_t*)(ws + WS_H);
    bf16_t* QKV = (bf16_t*)(ws + WS_QKV); bf16_t* O = (bf16_t*)(ws + WS_O); bf16_t* XQ = (bf16_t*)(ws + WS_XQ); bf16_t* XO = (bf16_t*)(ws + WS_XO);
    bf16_t* KVX = (bf16_t*)(ws + WS_KVX); bf16_t* MEMB = (bf16_t*)(ws + WS_MEMB); float* SC = (float*)(ws + WS_SCORES); u64* MASK = (u64*)(ws + WS_MASK);
    float* C = (float*)(ws + WS_C); f32x2* T128 = (f32x2*)(ws + WS_ROPE128); f32x2* T64 = (f32x2*)(ws + WS_ROPE64);
    for (int lj = 0; lj < 8; ++lj) launch_convert(stream, ffn_in + (size_t)lj * DM * 2 * FFN, 2 * FFN, 2 * FFN, DM, (bf16_t*)(ws + WS_WN_FFN_IN + lj * SZ_FFN_IN), 2 * FFN / 32, 0);
    for (int i = 0; i < 2; ++i) launch_convert(stream, even_in + (size_t)i * DM * EVEN_COLS, EVEN_COLS, EVEN_COLS, DM, (bf16_t*)(ws + WS_WN_EVEN_IN + i * SZ_WN_EVEN_IN), 5472 / 32, 0);
    int st = 0;
    while (st < N_STEPS) {
        StepInfo si = step_info(st);
        if (!si.valid) { ++st; continue; }
        if (FAST_MASK & si.flag) {
            int e = st + 1;
            while (e < N_STEPS) { StepInfo s2 = step_info(e); if (s2.valid && !(FAST_MASK & s2.flag)) break; ++e; }
            launch_mega(stream, base, st, e, grid, d_ws); st = e; continue;
        }
        const int l = si.l, kind = si.kind, i = l / 2;
        switch (si.flag) {
        case F_PROLOGUE: {
            for (int lj = 0; lj < 8; ++lj) {
                launch_convert(stream, ffn_in + (size_t)lj * DM * 2 * FFN, 2 * FFN, 2 * FFN, DM, (bf16_t*)(ws + WS_WF_FFN_IN + lj * SZ_FFN_IN), 2 * FFN / 32, 1);
                launch_convert(stream, ffn_out + (size_t)lj * FFN * DM, DM, DM, FFN, (bf16_t*)(ws + WS_W_FFN_OUT + lj * SZ_FFN_OUT), DM / 32, 0); }
            for (int ii = 0; ii < 2; ++ii) {
                launch_convert(stream, even_in + (size_t)ii * DM * EVEN_COLS, EVEN_COLS, EVEN_COLS, DM, (bf16_t*)(ws + WS_WF_EVEN_IN + ii * SZ_EVEN_IN), EVP / 32, 2);
                launch_convert(stream, odd_in + (size_t)ii * DM * ODD_COLS, ODD_COLS, ODD_COLS, DM, (bf16_t*)(ws + WS_W_ODD_IN + ii * SZ_ODD_IN), ODD_COLS / 32, 0);
                launch_convert(stream, even_out + (size_t)ii * DM * DM, DM, DM, DM, (bf16_t*)(ws + WS_W_MIX_OUT + (2 * ii) * SZ_MIX_OUT), DM / 32, 0);
                launch_convert(stream, odd_out + (size_t)ii * DM * DM, DM, DM, DM, (bf16_t*)(ws + WS_W_MIX_OUT + (2 * ii + 1) * SZ_MIX_OUT), DM / 32, 0); }
            for (int ll = 0; ll < DEPTH; ++ll) {
                launch_convert(stream, xq + (size_t)ll * DM * 512, 512, 512, DM, (bf16_t*)(ws + WS_W_XQ + ll * SZ_XQ), 512 / 32, 0);
                launch_convert(stream, xkv + (size_t)ll * DM * 1024, 1024, 1024, DM, (bf16_t*)(ws + WS_W_XKV + ll * SZ_XKV), 1024 / 32, 0);
                launch_convert(stream, xo + (size_t)ll * 512 * DM, DM, DM, 512, (bf16_t*)(ws + WS_W_XO + ll * SZ_XO), DM / 32, 0); }
            hipLaunchKernelGGL(k_rope_tables, dim3((SEQ * 96 + 255) / 256), dim3(256), 0, stream, T128, T64);
            hipLaunchKernelGGL(k_cvt_x, dim3(2048), dim3(256), 0, stream, x, X, XB, (size_t)MT * DM / 4);
            hipLaunchKernelGGL(k_cvt_x, dim3(1024), dim3(256), 0, stream, mem, (float*)nullptr, MEMB, (size_t)NB * MEML * DM / 4);
        } break;
        case F_KVX:
            launch_gemm(stream, MEMB, DM, (const bf16_t*)(ws + WS_W_XKV), DM, C, 4096, NB * MEML, 4096, DM);
            hipLaunchKernelGGL(k_tobf, dim3(2048), dim3(256), 0, stream, C, KVX, (size_t)1024 * 4096);
            break;
        case F_FFN_IN: { const int lj = l * 2 + (kind == 3 ? 1 : 0);
            launch_gemm(stream, XB, DM, (const bf16_t*)(ws + WS_WN_FFN_IN + lj * SZ_FFN_IN), DM, C, 2 * FFN, MT, 2 * FFN, DM);
            hipLaunchKernelGGL(k_swiglu, dim3(4096), dim3(256), 0, stream, C, H); } break;
        case F_EV_IN:
            launch_gemm(stream, XB, DM, (const bf16_t*)(ws + WS_WN_EVEN_IN + i * SZ_WN_EVEN_IN), DM, C, EVEN_COLS, MT, EVEN_COLS, DM);
            hipLaunchKernelGGL(k_even_split, dim3(4096), dim3(256), 0, stream, C, QKV, T128, T64);
            break;
        case F_IDXBAND: {
            hipLaunchKernelGGL(k_indexer_naive, dim3(1024), dim3(512), 8 * 8192, stream, QKV, SC);
            AttnArgs b2{}; b2.Q = QKV; b2.K = QKV; b2.V = QKV; b2.O = O; b2.bias = relb + (size_t)i * 8 * RELSZ; b2.mask = nullptr;
            b2.ldq = EVP; b2.qoff = EV_QB; b2.ldk = EVP; b2.koff = EV_KB; b2.ldv = EVP; b2.voff = EV_VB; b2.ldo = DM; b2.ooff = 1024; b2.nheads = 8; b2.kvshared = 0;
            hipLaunchKernelGGL(k_attn_naive<1>, dim3(512), dim3(512), 8 * 8704, stream, b2); } break;
        case F_DSA: if (si.sub == 2) { hipLaunchKernelGGL(k_select, dim3(1024), dim3(512), 0, stream, SC, MASK); break; } {
            AttnArgs a{}; a.Q = QKV; a.K = QKV; a.V = QKV; a.O = O; a.bias = nullptr; a.mask = MASK;
            a.ldq = EVP; a.qoff = EV_QA; a.ldk = EVP; a.koff = EV_KA; a.ldv = EVP; a.voff = EV_VA; a.ldo = DM; a.ooff = 0; a.nheads = 8; a.kvshared = 1;
            hipLaunchKernelGGL(k_attn_naive<2>, dim3(512), dim3(512), 8 * 8704, stream, a); } break;
        case F_OD_IN:
            launch_gemm(stream, XB, DM, (const bf16_t*)(ws + WS_W_ODD_IN + i * SZ_ODD_IN), DM, C, ODD_COLS, MT, ODD_COLS, DM);
            hipLaunchKernelGGL(k_tobf, dim3(4096), dim3(256), 0, stream, C, QKV, (size_t)MT * ODD_COLS);
            break;
        case F_STICK: {
            AttnArgs a{}; a.Q = QKV; a.K = QKV; a.V = QKV; a.O = O; a.bias = nullptr; a.mask = nullptr;
            a.ldq = ODD_COLS; a.qoff = 0; a.ldk = ODD_COLS; a.koff = 2048; a.ldv = ODD_COLS; a.voff = 4096; a.ldo = DM; a.ooff = 0; a.nheads = 16; a.kvshared = 0;
            hipLaunchKernelGGL(k_attn_naive<3>, dim3(512), dim3(512), 8 * 8704, stream, a); } break;
        case F_XQ:
            launch_gemm(stream, XB, DM, (const bf16_t*)(ws + WS_W_XQ + l * SZ_XQ), DM, C, 512, MT, 512, DM);
            hipLaunchKernelGGL(k_tobf, dim3(2048), dim3(256), 0, stream, C, XQ, (size_t)MT * 512);
            break;
        case F_XATT: {
            AttnArgs a{}; a.Q = XQ; a.K = KVX; a.V = KVX; a.O = XO; a.bias = nullptr; a.mask = nullptr;
            a.ldq = 512; a.qoff = 0; a.ldk = 4096; a.koff = l * 1024; a.ldv = 4096; a.voff = l * 1024 + 512; a.ldo = 512; a.ooff = 0; a.nheads = 4; a.kvshared = 0;
            hipLaunchKernelGGL(k_attn_naive<0>, dim3(512), dim3(512), 8 * 8704, stream, a); } break;
        case F_OUT: {
            const bf16_t* oA; const bf16_t* oB; int oK; float ocs;
            if (kind == 0 || kind == 3) { const int lj = l * 2 + (kind == 3 ? 1 : 0); oA = H; oB = (const bf16_t*)(ws + WS_W_FFN_OUT + lj * SZ_FFN_OUT); oK = FFN; ocs = 0.5f; }
            else if (kind == 1) { oA = O; oB = (const bf16_t*)(ws + WS_W_MIX_OUT + l * SZ_MIX_OUT); oK = DM; ocs = 1.f; }
            else { oA = XO; oB = (const bf16_t*)(ws + WS_W_XO + l * SZ_XO); oK = 512; ocs = 1.f; }
            launch_gemm(stream, oA, oK, oB, oK, C, DM, MT, DM, oK);
            hipLaunchKernelGGL(k_resid, dim3(4096), dim3(256), 0, stream, C, X, Y, ocs); } break;
        case F_LN:
            hipLaunchKernelGGL(k_ln, dim3(1024), dim3(512), 0, stream, Y, ln_g + (size_t)(l * 4 + kind) * DM, ln_b + (size_t)(l * 4 + kind) * DM, X, XB, si.sb == 15 ? (float*)d_out : (float*)nullptr);
            break;
        }
        ++st;
    }
    const hipError_t le = hipPeekAtLastError();
    if (le != hipSuccess) fprintf(stderr, "kernel_launch: launch failed: %s\n", hipGetErrorName(le));
}
```
